# Optimizing an MI355X kernel written in HIP

```python
import jax, jax.numpy as jnp
from jax import lax
import numpy as np

D_MODEL = 1024
BATCH = 2
SEQ = 8192
DEPTH = 1
DEC_BATCH = 16
DEC_SEQ = 2048
PAST_LEN = 128

HEAD_DIM = 64
RWKV_HEADS = 8
RWKV_W = RWKV_HEADS * HEAD_DIM
ATT_Q_HEADS = 8
ATT_KV_HEADS = 2
ATT_GROUP = ATT_Q_HEADS // ATT_KV_HEADS
ATT_W = ATT_Q_HEADS * HEAD_DIM
ATT_KV_W = ATT_KV_HEADS * HEAD_DIM
N_DIRS = 2
D_DECAY_LORA = 64
D_AAA_LORA = 64
D_GATE_LORA = 128
D_FF = 2816
GRID_W = 64
ROPE_THETA = 10000.0
ROPE_AXIS_DIM = HEAD_DIM // 2
Q_BLOCK = 128
NORM_EPS = 1e-6
LNX_EPS = 64e-5
L2_EPS = 1e-12

RWKV_SIZES = [RWKV_W, RWKV_W, RWKV_W, N_DIRS * D_DECAY_LORA, N_DIRS * D_AAA_LORA, D_GATE_LORA]
RWKV_COLS = sum(RWKV_SIZES)
ATT_SIZES = [ATT_W, ATT_KV_W, ATT_KV_W]
ATT_COLS = sum(ATT_SIZES)
GATE_COLS = 2 * D_MODEL
N_IN_COLS = RWKV_COLS + ATT_COLS + GATE_COLS

kernel_name = "hybrid_rwkv7_axial_gqa_encoder"


def _split(z, sizes):
    idx = np.cumsum(sizes)[:-1].tolist()
    return jnp.split(z, idx, axis=-1)


def rms_norm(x, g, eps=NORM_EPS):
    xf = x.astype(jnp.float32)
    y = xf * lax.rsqrt(jnp.mean(xf * xf, axis=-1, keepdims=True) + eps)
    return (y * g.astype(jnp.float32)).astype(x.dtype)


def swiglu(h, w_gate, w_up, w_down):
    return (jax.nn.silu(h @ w_gate) * (h @ w_up)) @ w_down


def centred_shift(p):
    prev = jnp.pad(p[:, :-1], ((0, 0), (1, 0), (0, 0)))
    nxt = jnp.pad(p[:, 1:], ((0, 0), (0, 1), (0, 0)))
    return 0.5 * (prev + nxt)


def _dir_major(z):
    B, T = z.shape[0], z.shape[1]
    z = jnp.stack([z[:, :, 0], z[:, ::-1, 1]], axis=0)
    z = z.reshape(N_DIRS, B, T, RWKV_HEADS, HEAD_DIM)
    return jnp.transpose(z, (2, 0, 1, 3, 4))


def _rwkv7_step(S, inp):
    r, w, k, v, kk, b = inp
    sa = jnp.einsum('dbhij,dbhj->dbhi', S, -kk)
    S = S * w[..., None, :] + sa[..., :, None] * b[..., None, :] + v[..., :, None] * k[..., None, :]
    y = jnp.einsum('dbhij,dbhj->dbhi', S, r)
    return S, y


def rwkv7_bidir(p_rw, mu, w0, w_up, a0, a_up, g_up, k_k, k_a, r_k, lnx_w, lnx_b):
    f32 = jnp.float32
    B, T, _ = p_rw.shape
    xs = p_rw + (centred_shift(p_rw) - p_rw) * mu
    r, k, v, wd, ad, gd = _split(xs, RWKV_SIZES)
    wd = wd.reshape(B, T, N_DIRS, D_DECAY_LORA)
    ad = ad.reshape(B, T, N_DIRS, D_AAA_LORA)
    w_log = -jax.nn.softplus(-(w0 + jnp.einsum('btdr,drc->btdc', jnp.tanh(wd), w_up)).astype(f32)) - 0.5
    decay = jnp.exp(-jnp.exp(w_log))
    a = jax.nn.sigmoid((a0 + jnp.einsum('btdr,drc->btdc', ad, a_up)).astype(f32))
    g = (jax.nn.sigmoid(gd) @ g_up).astype(f32)
    kk = (k * k_k).astype(f32).reshape(B, T, RWKV_HEADS, HEAD_DIM)
    kk = kk / jnp.maximum(jnp.linalg.norm(kk, axis=-1, keepdims=True), L2_EPS)
    kk = kk.reshape(B, T, 1, RWKV_W)
    r32 = r.astype(f32)[:, :, None]
    v32 = v.astype(f32)[:, :, None]
    k_dir = k.astype(f32)[:, :, None] * (1.0 + (a - 1.0) * k_a.astype(f32))
    b_dir = kk * a
    ones = jnp.ones((1, 1, N_DIRS, 1), f32)
    seq_in = (_dir_major(r32 * ones), _dir_major(decay), _dir_major(k_dir),
              _dir_major(v32 * ones), _dir_major(kk * ones), _dir_major(b_dir))
    S0 = jnp.zeros((N_DIRS, B, RWKV_HEADS, HEAD_DIM, HEAD_DIM), f32)
    _, y = lax.scan(_rwkv7_step, S0, seq_in)
    y = jnp.transpose(y, (1, 2, 0, 3, 4))
    y = y[0] + y[1][:, ::-1]
    mean = jnp.mean(y, axis=-1, keepdims=True)
    var = jnp.mean(jnp.square(y - mean), axis=-1, keepdims=True)
    y = ((y - mean) * lax.rsqrt(var + LNX_EPS)).reshape(B, T, RWKV_W)
    y = y * lnx_w.astype(f32) + lnx_b.astype(f32)
    coef = jnp.sum((r32 * k_dir).reshape(B, T, N_DIRS, RWKV_HEADS, HEAD_DIM) * r_k.astype(f32), axis=(2, 4))
    bonus = (coef[..., None] * v.astype(f32).reshape(B, T, RWKV_HEADS, HEAD_DIM)).reshape(B, T, RWKV_W)
    return ((y + bonus) * g).astype(p_rw.dtype)


def axial_rope_tables(T):
    rows = T // GRID_W
    r_idx, c_idx = jnp.meshgrid(jnp.arange(rows, dtype=jnp.float32),
                                jnp.arange(GRID_W, dtype=jnp.float32), indexing='ij')
    r_idx = r_idx.reshape(T)
    c_idx = c_idx.reshape(T)
    inv_freq = ROPE_THETA ** (-jnp.arange(0, ROPE_AXIS_DIM, 2, dtype=jnp.float32) / ROPE_AXIS_DIM)
    ang = jnp.concatenate([r_idx[:, None] * inv_freq, c_idx[:, None] * inv_freq], axis=-1)
    return jnp.cos(ang), jnp.sin(ang)


def apply_rope(x, cos, sin):
    B, T, H, N = x.shape
    xf = x.astype(jnp.float32).reshape(B, T, H, N // 2, 2)
    x0, x1 = xf[..., 0], xf[..., 1]
    c = cos[None, :, None, :]
    s = sin[None, :, None, :]
    out = jnp.stack([x0 * c - x1 * s, x0 * s + x1 * c], axis=-1)
    return out.reshape(B, T, H, N).astype(x.dtype)


def axial_gqa(p_att, qk_g):
    B, T, _ = p_att.shape
    q, k, v = _split(p_att, ATT_SIZES)
    cos, sin = axial_rope_tables(T)
    q = apply_rope(rms_norm(q.reshape(B, T, ATT_Q_HEADS, HEAD_DIM), qk_g[0]), cos, sin)
    k = apply_rope(rms_norm(k.reshape(B, T, ATT_KV_HEADS, HEAD_DIM), qk_g[1]), cos, sin)
    v = v.reshape(B, T, ATT_KV_HEADS, HEAD_DIM)
    n_blk = T // Q_BLOCK
    qb = q.reshape(B, n_blk, Q_BLOCK, ATT_KV_HEADS, ATT_GROUP, HEAD_DIM)
    qb = jnp.transpose(qb, (1, 0, 3, 4, 2, 5))
    kt = jnp.transpose(k, (0, 2, 1, 3))
    vt = jnp.transpose(v, (0, 2, 1, 3))
    scale = HEAD_DIM ** -0.5

    def block(q_blk):
        s = jnp.einsum('bhgqd,bhkd->bhgqk', q_blk, kt).astype(jnp.float32) * scale
        p = jax.nn.softmax(s, axis=-1)
        return jnp.einsum('bhgqk,bhkd->bhgqd', p.astype(vt.dtype), vt)

    o = lax.map(block, qb)
    o = jnp.transpose(o, (1, 0, 4, 2, 3, 5))
    return o.reshape(B, T, ATT_W)


def encoder_layer(x, norm_g, ffn_w_gate, ffn_w_up, ffn_w_down, w_in, mu_shift, w0, w_lora_up,
                  a0, a_lora_up, g_lora_up, k_k, k_a, r_k, lnx_w, lnx_b, qk_norm_g,
                  w_branch_a, w_branch_b, b_gate, w_out):
    h = rms_norm(x, norm_g[0])
    x = x + 0.5 * rms_norm(swiglu(h, ffn_w_gate[0], ffn_w_up[0], ffn_w_down[0]), norm_g[1])
    h = rms_norm(x, norm_g[2])
    p = h @ w_in
    p_rw, p_att, p_gate = _split(p, [RWKV_COLS, ATT_COLS, GATE_COLS])
    y_a = rwkv7_bidir(p_rw, mu_shift, w0, w_lora_up, a0, a_lora_up, g_lora_up,
                      k_k, k_a, r_k, lnx_w, lnx_b)
    y_b = axial_gqa(p_att, qk_norm_g)
    g_a, g_b = _split(jax.nn.sigmoid(p_gate + b_gate.reshape(GATE_COLS)), [D_MODEL, D_MODEL])
    merged = g_a * (y_a @ w_branch_a) + g_b * (y_b @ w_branch_b)
    x = x + rms_norm(merged @ w_out, norm_g[3])
    h = rms_norm(x, norm_g[4])
    x = x + 0.5 * rms_norm(swiglu(h, ffn_w_gate[1], ffn_w_up[1], ffn_w_down[1]), norm_g[5])
    return x


def setup_inputs(seed: int = 0) -> dict:
    key = jax.random.key(seed)
    ks = jax.random.split(key, 24)
    f32 = jnp.float32
    L = DEPTH
    nrm = lambda k, shape, s: jax.random.normal(k, shape, f32) * s
    return {
        "x_prompt": jax.random.normal(ks[0], (BATCH, SEQ, D_MODEL), f32),
        "x_sample": jax.random.normal(ks[1], (DEC_BATCH, DEC_SEQ, D_MODEL), f32),
        "norm_g": 1.0 + nrm(ks[2], (L, 6, D_MODEL), 0.05),
        "ffn_w_gate": nrm(ks[3], (L, 2, D_MODEL, D_FF), D_MODEL ** -0.5),
        "ffn_w_up": nrm(ks[4], (L, 2, D_MODEL, D_FF), D_MODEL ** -0.5),
        "ffn_w_down": nrm(ks[5], (L, 2, D_FF, D_MODEL), D_FF ** -0.5),
        "w_in": nrm(ks[6], (L, D_MODEL, N_IN_COLS), D_MODEL ** -0.5),
        "mu_shift": jax.random.uniform(ks[7], (L, RWKV_COLS), f32, 0.1, 0.9),
        "w0": nrm(ks[8], (L, N_DIRS, RWKV_W), 0.5),
        "w_lora_up": nrm(ks[9], (L, N_DIRS, D_DECAY_LORA, RWKV_W), 0.1 * D_DECAY_LORA ** -0.5),
        "a0": nrm(ks[10], (L, N_DIRS, RWKV_W), 0.5),
        "a_lora_up": nrm(ks[11], (L, N_DIRS, D_AAA_LORA, RWKV_W), 0.1 * D_AAA_LORA ** -0.5),
        "g_lora_up": nrm(ks[12], (L, D_GATE_LORA, RWKV_W), D_GATE_LORA ** -0.5),
        "k_k": 0.85 + nrm(ks[13], (L, RWKV_W), 0.05),
        "k_a": 1.0 + nrm(ks[14], (L, RWKV_W), 0.05),
        "r_k": nrm(ks[15], (L, RWKV_HEADS, HEAD_DIM), 0.1),
        "lnx_w": 1.0 + nrm(ks[16], (L, RWKV_W), 0.05),
        "lnx_b": nrm(ks[17], (L, RWKV_W), 0.01),
        "qk_norm_g": 1.0 + nrm(ks[18], (L, 2, HEAD_DIM), 0.05),
        "w_branch_a": nrm(ks[19], (L, RWKV_W, D_MODEL), RWKV_W ** -0.5),
        "w_branch_b": nrm(ks[20], (L, ATT_W, D_MODEL), ATT_W ** -0.5),
        "b_gate": nrm(ks[21], (L, 2, D_MODEL), 0.01),
        "w_out": nrm(ks[22], (L, D_MODEL, D_MODEL), D_MODEL ** -0.5),
    }


def reference(x_prompt, x_sample, norm_g, ffn_w_gate, ffn_w_up, ffn_w_down, w_in, mu_shift,
              w0, w_lora_up, a0, a_lora_up, g_lora_up, k_k, k_a, r_k, lnx_w, lnx_b,
              qk_norm_g, w_branch_a, w_branch_b, b_gate, w_out):
    def trunk(x):
        for l in range(DEPTH):
            x = encoder_layer(x, norm_g[l], ffn_w_gate[l], ffn_w_up[l], ffn_w_down[l], w_in[l],
                              mu_shift[l], w0[l], w_lora_up[l], a0[l], a_lora_up[l], g_lora_up[l],
                              k_k[l], k_a[l], r_k[l], lnx_w[l], lnx_b[l], qk_norm_g[l],
                              w_branch_a[l], w_branch_b[l], b_gate[l], w_out[l])
        return x

    y_prompt = trunk(x_prompt)
    y_sample = trunk(x_sample)
    return (y_prompt, y_sample)
```

```cpp
#include <hip/hip_runtime.h>
#include <hip/hip_cooperative_groups.h>
#include <cstdio>
#include <cstdint>
namespace cg = cooperative_groups;

typedef unsigned short bf16_t;
typedef short bf16x8 __attribute__((ext_vector_type(8)));
typedef short s16x4 __attribute__((ext_vector_type(4)));
typedef float f32x2 __attribute__((ext_vector_type(2)));
typedef float f32x4 __attribute__((ext_vector_type(4)));
typedef float f32x16 __attribute__((ext_vector_type(16)));
typedef unsigned u32x2 __attribute__((ext_vector_type(2)));
typedef unsigned u32x4 __attribute__((ext_vector_type(4)));
typedef __bf16 bf16x2n __attribute__((ext_vector_type(2)));
#define DI __device__ __forceinline__

constexpr int MTOK = 49152, MPROMPT = 16384, DM = 1024, DFF = 2816, NPC = 2688  , NPCPAD = 2816;
constexpr int TP = 8192, TS = 2048;
constexpr size_t MiB = 1024ull * 1024ull;
constexpr size_t WS_WFFN1GU = 0;
constexpr size_t WS_WFFN1D  = WS_WFFN1GU + 5632ull * 1024 * 2;
constexpr size_t WS_WFFN2GU = WS_WFFN1D + 1024ull * 2816 * 2;
constexpr size_t WS_WFFN2D  = WS_WFFN2GU + 5632ull * 1024 * 2;
constexpr size_t WS_WIN     = WS_WFFN2D + 1024ull * 2816 * 2;
constexpr size_t WS_WG      = WS_WIN + 2816ull * 1024 * 2;
constexpr size_t WS_WA      = WS_WG + 2048ull * 1024 * 2;
constexpr size_t WS_WB      = WS_WA + 1024ull * 512 * 2;
constexpr size_t WS_WOUT    = WS_WB + 1024ull * 512 * 2;
constexpr size_t WS_WUPT    = WS_WOUT + 1024ull * 1024 * 2;
constexpr size_t WS_AUPT    = WS_WUPT + 2ull * 512 * 64 * 2;
constexpr size_t WS_GUPT    = WS_AUPT + 2ull * 512 * 64 * 2;
constexpr size_t WS_R0END   = WS_GUPT + 512ull * 128 * 2;
constexpr size_t WS_BAR     = 47 * MiB;
static_assert(WS_R0END <= WS_BAR, "barrier words");
static_assert(WS_R0END <= 48 * MiB, "weights region");
constexpr size_t R1 = 48 * MiB;
constexpr size_t R2 = 312 * MiB;
constexpr size_t R3 = 408 * MiB;
constexpr size_t WS_HFF1 = R1, WS_P = R1, WS_H = R2, WS_F1 = R3;
constexpr size_t WS_NBUF = R2, WS_PBUF = R2 + 48 * MiB;
constexpr size_t WS_YDIR = R2 + 48 * MiB;
constexpr size_t WS_COEF = 456 * MiB;
constexpr size_t WS_KB   = 440 * MiB;
constexpr size_t WS_VT   = 452 * MiB;
constexpr size_t WS_QB   = 464 * MiB;
constexpr size_t WS_YA   = R2;
constexpr size_t WS_H2B  = R1;
constexpr size_t WS_MERGED = R1 + 96 * MiB;
constexpr size_t WS_SCR  = R1 + 192 * MiB;
constexpr size_t WS_O    = 368 * MiB;
constexpr size_t WS_H3   = R1;
constexpr size_t WS_HFF2 = R1 + 96 * MiB;
constexpr size_t WS_F2   = R3;
constexpr size_t WS_NEED = 512 * MiB;

struct Params {
    const float* xp; const float* xs; const float* norm_g; const float* ffn_wg; const float* ffn_wu; const float* ffn_wd;
    const float* w_in; const float* mu; const float* w0; const float* w_up; const float* a0; const float* a_up; const float* g_up;
    const float* k_k; const float* k_a; const float* r_k; const float* lnx_w; const float* lnx_b; const float* qk_g;
    const float* w_ba; const float* w_bb; const float* b_gate; const float* w_out;
    float* out; unsigned char* ws;
};

DI unsigned pk2(float lo, float hi) { f32x2 v = {lo, hi}; bf16x2n b = __builtin_convertvector(v, bf16x2n); return __builtin_bit_cast(unsigned, b); }
DI bf16_t f2bf(float x) { return (bf16_t)(pk2(x, 0.f) & 0xffffu); }
DI float bf2f(bf16_t b) { return __uint_as_float(((unsigned)b) << 16); }
DI float bflo(unsigned u) { return __uint_as_float(u << 16); }
DI float bfhi(unsigned u) { return __uint_as_float(u & 0xffff0000u); }
DI void unpack8(u32x4 u, float* f) { f[0] = bflo(u.x); f[1] = bfhi(u.x); f[2] = bflo(u.y); f[3] = bfhi(u.y); f[4] = bflo(u.z); f[5] = bfhi(u.z); f[6] = bflo(u.w); f[7] = bfhi(u.w); }
DI u32x4 pack8(const float* f) { u32x4 u; u.x = pk2(f[0], f[1]); u.y = pk2(f[2], f[3]); u.z = pk2(f[4], f[5]); u.w = pk2(f[6], f[7]); return u; }
DI int crow(int reg, int h) { return (reg & 3) + 8 * (reg >> 2) + 4 * h; }
#define MFMA32(a, b, c) __builtin_amdgcn_mfma_f32_32x32x16_bf16((a), (b), (c), 0, 0, 0)
DI bf16x8 pack_step(const f32x16& x, int s) {
    u32x4 p; p.x = pk2(x[8 * s], x[8 * s + 1]); p.y = pk2(x[8 * s + 2], x[8 * s + 3]); p.z = pk2(x[8 * s + 4], x[8 * s + 5]); p.w = pk2(x[8 * s + 6], x[8 * s + 7]);
    return __builtin_bit_cast(bf16x8, p);
}
DI const float* xrow(const Params& p, int m) { return m < MPROMPT ? p.xp + (size_t)m * DM : p.xs + (size_t)(m - MPROMPT) * DM; }
DI float wave_sum(float v) {
#pragma unroll
    for (int o = 1; o < 64; o <<= 1) v += __shfl_xor(v, o);
    return v;
}
DI float sigmoidf_(float x) { return __builtin_amdgcn_rcpf(1.f + __expf(-x)); }
DI float tanhf_(float x) { return 1.f - 2.f * __builtin_amdgcn_rcpf(1.f + __builtin_amdgcn_exp2f(x * 2.8853900817779268f)); }
DI float sum8_dpp(float v) {
    v += __int_as_float(__builtin_amdgcn_mov_dpp(__float_as_int(v), 0xB1, 0xF, 0xF, false));
    v += __int_as_float(__builtin_amdgcn_mov_dpp(__float_as_int(v), 0x4E, 0xF, 0xF, false));
    v += __int_as_float(__builtin_amdgcn_mov_dpp(__float_as_int(v), 0x141, 0xF, 0xF, false));
    return v;
}
DI int tid_() { int t = threadIdx.x; asm volatile("" : "+v"(t)); return t; }

extern __shared__ __attribute__((aligned(16))) unsigned char smem[];
constexpr int LDS_MAIN = 161280;
constexpr int LDS_BYTES = LDS_MAIN + 16;

DI void transpose_item(const float* W, int ldw, int K, int k0, int nsrc, bf16_t* WT, int dstrow, float* scr, int lane) {
#pragma unroll
    for (int i = 0; i < 8; ++i) { const int kk = 8 * i + (lane >> 3), n4 = (lane & 7) * 4; const f32x4 v = *(const f32x4*)(W + (size_t)(k0 + kk) * ldw + nsrc + n4);
        float* d = scr + kk * 33 + n4; d[0] = v[0]; d[1] = v[1]; d[2] = v[2]; d[3] = v[3]; }
    __builtin_amdgcn_fence(__ATOMIC_RELEASE, "wavefront"); __builtin_amdgcn_wave_barrier(); __builtin_amdgcn_fence(__ATOMIC_ACQUIRE, "wavefront");
    const int c = lane & 7;
#pragma unroll
    for (int j = 0; j < 4; ++j) { const int n = (lane >> 3) + 8 * j; const float* s = scr + (8 * c) * 33 + n;
        u32x4 o; o.x = pk2(s[0 * 33], s[1 * 33]); o.y = pk2(s[2 * 33], s[3 * 33]); o.z = pk2(s[4 * 33], s[5 * 33]); o.w = pk2(s[6 * 33], s[7 * 33]);
        *(u32x4*)(WT + (size_t)(dstrow + n) * K + k0 + 8 * c) = o; }
    __builtin_amdgcn_fence(__ATOMIC_RELEASE, "wavefront"); __builtin_amdgcn_wave_barrier(); __builtin_amdgcn_fence(__ATOMIC_ACQUIRE, "wavefront");
}
struct TJob { const float* W; int ldw, K, ncol0, ncols; bf16_t* WT; int dstrow0; int mode; };
DI int tjob_items(const TJob& j) { return (j.K / 64) * (j.ncols / 32); }
DI void tjob_run(const TJob& j, int item, float* scr, int lane) {
    const int nblk = j.ncols / 32, kb = item / nblk, nb = item % nblk, n0 = 32 * nb;
    int drow = j.dstrow0 + n0;
    if (j.mode) drow = 256 * (n0 >> 7) + (j.mode == 2 ? 128 : 0) + (n0 & 127);
    transpose_item(j.W, j.ldw, j.K, 64 * kb, j.ncol0 + n0, j.WT, drow, scr, lane);
}

DI void row_phase(const Params& p, int mode, const bf16_t* fbuf, float scale, const float* gpost, const float* gpre, bf16_t* hbuf, int gw, int ngw, int lane) {
    for (int m = gw; m < MTOK; m += ngw) {
        const float* xr = (mode <= 1) ? xrow(p, m) : p.out + (size_t)m * DM;
        f32x4 v[4];
#pragma unroll
        for (int j = 0; j < 4; ++j) v[j] = *(const f32x4*)(xr + 4 * lane + 256 * j);
        if (mode == 1 || mode == 2) {
            const bf16_t* fr = fbuf + (size_t)m * DM;
            f32x4 f[4]; float ss = 0.f;
#pragma unroll
            for (int j = 0; j < 4; ++j) { u32x2 u = *(const u32x2*)(fr + 4 * lane + 256 * j); f[j] = (f32x4){bflo(u.x), bfhi(u.x), bflo(u.y), bfhi(u.y)};
                ss += f[j].x * f[j].x + f[j].y * f[j].y + f[j].z * f[j].z + f[j].w * f[j].w; }
            const float rs = rsqrtf(wave_sum(ss) * (1.f / DM) + 1e-6f) * scale;
#pragma unroll
            for (int j = 0; j < 4; ++j) { const f32x4 g = *(const f32x4*)(gpost + 4 * lane + 256 * j); v[j] = v[j] + f[j] * g * rs; }
            float* xo = p.out + (size_t)m * DM;
#pragma unroll
            for (int j = 0; j < 4; ++j) *(f32x4*)(xo + 4 * lane + 256 * j) = v[j];
        }
        if (hbuf) {
            float ss = 0.f;
#pragma unroll
            for (int j = 0; j < 4; ++j) ss += v[j].x * v[j].x + v[j].y * v[j].y + v[j].z * v[j].z + v[j].w * v[j].w;
            const float rs = rsqrtf(wave_sum(ss) * (1.f / DM) + 1e-6f);
            bf16_t* hr = hbuf + (size_t)m * DM;
#pragma unroll
            for (int j = 0; j < 4; ++j) { const f32x4 g = *(const f32x4*)(gpre + 4 * lane + 256 * j); const f32x4 y = v[j] * g * rs;
                u32x2 o; o.x = pk2(y.x, y.y); o.y = pk2(y.z, y.w); *(u32x2*)(hr + 4 * lane + 256 * j) = o; }
        }
    }
}

constexpr int BM = 256, BK = 64, HALF = 128, NXCD = 8, WGM = 8, HT = HALF * BK;
DI int lds_byte(int r, int c) { int st = (r >> 4) * 2 + (c >> 5), rr = r & 15, cc = c & 31, ob = rr * 64 + cc * 2; return st * 1024 + (ob ^ (((ob >> 9) & 1) << 5)); }
DI void stage_rc(int b, int& R, int& C) { int st = b / 1024, sb = b % 1024, swz = sb ^ (((sb >> 9) & 1) << 5); R = (st >> 1) * 16 + swz / 64; C = (st & 1) * 32 + (swz % 64) / 2; }
DI bool tile_order(int nM, int nN, int i, int G, int c, int& pm, int& pn) {
    const int nwg = nM * nN; const long L = (long)i * G + c; if (L >= nwg) return false;
    int wgid = (int)L; { const int q = nwg / NXCD, r = nwg % NXCD, xcd = wgid % NXCD, off = wgid / NXCD; wgid = (xcd < r ? xcd * (q + 1) : r * (q + 1) + (xcd - r) * q) + off; }
    const int nig = WGM * nN, gid = wgid / nig, fm = gid * WGM, gsz = (nM - fm) < WGM ? (nM - fm) : WGM;
    pm = fm + ((wgid % nig) % gsz); pn = (wgid % nig) / gsz; return true;
}
#define ACC_T f32x4 (&acc)[2][2][4][2]
template <class Epi>
DI void gemm_tile(const bf16_t* __restrict__ A, const bf16_t* __restrict__ Bt, int K, int brow, int bcol, const Epi& epi,
               bool pre  , bool hasNext, const bf16_t* An, const bf16_t* Btn, int Kn, int brown, int bcoln) {
    bf16_t* shm = (bf16_t*)smem;
#define SA(b, h) (shm + ((b) * 2 + (h)) * HT)
#define SB(b, h) (shm + (4 + (b) * 2 + (h)) * HT)
#define STAGEX(P, BASE, br, kt, K_, voff_) do { const char* _gb = (const char*)(BASE) + ((long)(br) * (K_) + (long)(kt) * BK) * 2; \
    _Pragma("unroll") for (int _i = 0; _i < 2; ++_i) \
      __builtin_amdgcn_global_load_lds((const unsigned*)(_gb + voff_[_i]), (unsigned*)((char*)(P) + wid * 1024 + _i * 8192), 16, 0, 0); } while (0)
#define STAGE(P, BASE, br, kt) STAGEX(P, BASE, br, kt, K, voff)
#define LDA(dst, b, h) for (int m = 0; m < 4; ++m) for (int k = 0; k < 2; ++k) \
    dst[m][k] = *reinterpret_cast<const bf16x8*>((char*)SA(b, h) + lds_byte(wr * 64 + m * 16 + fr, k * 32 + fq * 8))
#define LDB(dst, b, h) for (int n = 0; n < 2; ++n) for (int k = 0; k < 2; ++k) \
    dst[n][k] = *reinterpret_cast<const bf16x8*>((char*)SB(b, h) + lds_byte(wc * 32 + n * 16 + fr, k * 32 + fq * 8))
#define MMA(ai, bj, At_, Bt_) do { __builtin_amdgcn_s_setprio(1); \
    for (int m = 0; m < 4; ++m) for (int n = 0; n < 2; ++n) for (int k = 0; k < 2; ++k) \
      acc[ai][bj][m][n] = __builtin_amdgcn_mfma_f32_16x16x32_bf16(Bt_[n][k], At_[m][k], acc[ai][bj][m][n], 0, 0, 0); \
    __builtin_amdgcn_s_setprio(0); } while (0)
#define WAIT_V(n) asm volatile("s_waitcnt vmcnt(" #n ")" ::: "memory")
#define WAIT_L(n) asm volatile("s_waitcnt lgkmcnt(" #n ")" ::: "memory")
#define BAR __builtin_amdgcn_s_barrier()
#define SCHED __builtin_amdgcn_sched_barrier(0)
    const int tid = tid_(), wid = __builtin_amdgcn_readfirstlane(tid >> 6), lane = tid & 63, wr = wid >> 2, wc = wid & 3, fr = lane & 15, fq = lane >> 4;
    unsigned voff[2];
#pragma unroll
    for (int i = 0; i < 2; ++i) { int R, C; stage_rc(tid * 16 + i * 8192, R, C); voff[i] = (unsigned)(R * K + C) * 2u; }
    f32x4 acc[2][2][4][2] = {};
    bf16x8 At[4][2], B0[2][2], B1[2][2];
    const int nt = K / BK;
    if (!pre) { STAGE(SB(0, 0), Bt, bcol, 0); STAGE(SA(0, 0), A, brow, 0);
                STAGE(SB(0, 1), Bt, bcol + HALF, 0); STAGE(SA(0, 1), A, brow + HALF, 0); }
    if (wr == 1) BAR;
    if (pre) WAIT_V(0); else WAIT_V(4);
    BAR;
    STAGE(SB(1, 0), Bt, bcol, 1); STAGE(SA(1, 0), A, brow, 1); STAGE(SB(1, 1), Bt, bcol + HALF, 1);
    WAIT_V(6); BAR;
#pragma unroll 1
    for (int t = 0; t < nt - 2; t += 2) {
        LDB(B0, 0, 0); SCHED; LDA(At, 0, 0); STAGE(SA(1, 1), A, brow + HALF, t + 1);
        WAIT_L(8); BAR; WAIT_L(0); MMA(0, 0, At, B0); BAR; SCHED;
        LDB(B1, 0, 1); STAGE(SB(0, 0), Bt, bcol, t + 2);
        BAR; WAIT_L(0); MMA(0, 1, At, B1); BAR;
        LDA(At, 0, 1); STAGE(SA(0, 0), A, brow, t + 2);
        BAR; WAIT_L(0); MMA(1, 0, At, B0); BAR; SCHED;
        STAGE(SB(0, 1), Bt, bcol + HALF, t + 2);
        WAIT_V(6); BAR; MMA(1, 1, At, B1); BAR;
        LDB(B0, 1, 0); SCHED; LDA(At, 1, 0); STAGE(SA(0, 1), A, brow + HALF, t + 2);
        WAIT_L(8); BAR; WAIT_L(0); MMA(0, 0, At, B0); BAR; SCHED;
        LDB(B1, 1, 1); STAGE(SB(1, 0), Bt, bcol, t + 3);
        BAR; WAIT_L(0); MMA(0, 1, At, B1); BAR;
        LDA(At, 1, 1); STAGE(SA(1, 0), A, brow, t + 3);
        BAR; WAIT_L(0); MMA(1, 0, At, B0); BAR; SCHED;
        STAGE(SB(1, 1), Bt, bcol + HALF, t + 3);
        WAIT_V(6); BAR; MMA(1, 1, At, B1); BAR;
    }
    { LDB(B0, 0, 0); LDA(At, 0, 0); STAGE(SA(1, 1), A, brow + HALF, nt - 1);
      BAR; WAIT_L(0); MMA(0, 0, At, B0); BAR;
      LDB(B1, 0, 1); BAR; WAIT_L(0); MMA(0, 1, At, B1); BAR;
      LDA(At, 0, 1); WAIT_V(4); BAR; WAIT_L(0); MMA(1, 0, At, B0); MMA(1, 1, At, B1); BAR; }
    { LDB(B0, 1, 0); LDA(At, 1, 0); WAIT_V(2); BAR; WAIT_L(0); MMA(0, 0, At, B0); BAR;
      LDB(B1, 1, 1); WAIT_V(0); BAR; WAIT_L(0); MMA(0, 1, At, B1); BAR;
      LDA(At, 1, 1); BAR; WAIT_L(0); MMA(1, 0, At, B0); MMA(1, 1, At, B1); BAR; }
    if (wr == 0) BAR;
    if (hasNext) {
        unsigned voffn[2];
#pragma unroll
        for (int i = 0; i < 2; ++i) { int R, C; stage_rc(tid * 16 + i * 8192, R, C); voffn[i] = (unsigned)(R * Kn + C) * 2u; }
        STAGEX(SB(0, 0), Btn, bcoln, 0, Kn, voffn); STAGEX(SA(0, 0), An, brown, 0, Kn, voffn);
        STAGEX(SB(0, 1), Btn, bcoln + HALF, 0, Kn, voffn); STAGEX(SA(0, 1), An, brown + HALF, 0, Kn, voffn);
    }
    SCHED;
    epi(acc, brow, bcol, wr, wc, fr, fq);
#undef SA
#undef SB
}

struct EpiAny {
    int kind; bf16_t* O; int ldc; int ncols;
    bf16_t* T; int ldt; int trow0, tcol0; const float* bias; const bf16_t* S1;
    DI void operator()(ACC_T, int brow, int bcol, int wr, int wc, int fr, int fq) const {
        if (kind <= 1) {
            unsigned char* L = smem;
            if (kind == 0) {
#pragma unroll
                for (int ai = 0; ai < 2; ++ai)
#pragma unroll
                    for (int m = 0; m < 4; ++m) { const int row = ai * HALF + wr * 64 + m * 16 + fr;
#pragma unroll
                        for (int bj = 0; bj < 2; ++bj)
#pragma unroll
                            for (int n = 0; n < 2; ++n) { const f32x4 v = acc[ai][bj][m][n]; const int slot = (bj * 32 + wc * 8 + n * 4 + fq + 4 * fr) & 63;
                                u32x2 o; o.x = pk2(v[0], v[1]); o.y = pk2(v[2], v[3]); *(u32x2*)(L + row * 512 + slot * 8) = o; } }
            } else {
#pragma unroll
                for (int ai = 0; ai < 2; ++ai)
#pragma unroll
                    for (int m = 0; m < 4; ++m) { const int row = ai * HALF + wr * 64 + m * 16 + fr;
#pragma unroll
                        for (int n = 0; n < 2; ++n) { const f32x4 g = acc[ai][0][m][n], u = acc[ai][1][m][n]; float r[4];
#pragma unroll
                            for (int j = 0; j < 4; ++j) r[j] = g[j] * __builtin_amdgcn_rcpf(1.f + __expf(-g[j])) * u[j];
                            const int slot = (wc * 8 + n * 4 + fq + 4 * fr) & 31;
                            u32x2 o; o.x = pk2(r[0], r[1]); o.y = pk2(r[2], r[3]); *(u32x2*)(L + row * 256 + slot * 8) = o; } }
            }
            asm volatile("s_waitcnt lgkmcnt(0)" ::: "memory"); __builtin_amdgcn_s_barrier(); asm volatile("" ::: "memory");
            const int tid = (wr * 4 + wc) * 64 + fq * 16 + fr;
            if (kind == 0) {
#pragma unroll
                for (int k = 0; k < 16; ++k) { const int pp = tid + 512 * k, row = pp >> 5, pc = pp & 31, slot = (2 * pc + 4 * (row & 15)) & 63;
                    const u32x4 v = *(const u32x4*)(L + row * 512 + slot * 8); const int col = bcol + pc * 8;
                    if (col < ncols) *(u32x4*)(O + (size_t)(brow + row) * ldc + col) = v; }
            } else {
#pragma unroll
                for (int k = 0; k < 8; ++k) { const int pp = tid + 512 * k, row = pp >> 4, pc = pp & 15, slot = (2 * pc + 4 * (row & 15)) & 31;
                    const u32x4 v = *(const u32x4*)(L + row * 256 + slot * 8);
                    *(u32x4*)(O + (size_t)(brow + row) * DFF + (bcol >> 1) + pc * 8) = v; }
            }
            asm volatile("s_waitcnt lgkmcnt(0)" ::: "memory"); __builtin_amdgcn_s_barrier(); asm volatile("" ::: "memory");
            return;
        }
        unsigned char* L = smem;
        const int tid = (wr * 4 + wc) * 64 + fq * 16 + fr;
#define EPI_BAR do { asm volatile("s_waitcnt lgkmcnt(0)" ::: "memory"); __builtin_amdgcn_s_barrier(); asm volatile("" ::: "memory"); } while (0)
#define EPI_WIDE_LOAD(PTR_, LD_, R0_, C0_) do { _Pragma("unroll 1") for (int k4 = 0; k4 < 16; k4 += 2) _Pragma("unroll") for (int k = k4; k < k4 + 2; ++k) { const int pp = tid + 512 * k, row = pp >> 5, pc = pp & 31, slot = (2 * pc + 4 * (row & 15)) & 63; \
            *(u32x4*)(L + row * 512 + slot * 8) = *(const u32x4*)((PTR_) + (size_t)(brow + row - (R0_)) * (LD_) + (bcol + pc * 8 - (C0_))); } } while (0)
#define EPI_WIDE_STORE(PTR_, LD_, R0_, C0_) do { _Pragma("unroll 1") for (int k4 = 0; k4 < 16; k4 += 2) _Pragma("unroll") for (int k = k4; k < k4 + 2; ++k) { const int pp = tid + 512 * k, row = pp >> 5, pc = pp & 31, slot = (2 * pc + 4 * (row & 15)) & 63; \
            *(u32x4*)((PTR_) + (size_t)(brow + row - (R0_)) * (LD_) + (bcol + pc * 8 - (C0_))) = *(const u32x4*)(L + row * 512 + slot * 8); } } while (0)
#define EPI_SLOT(ai_, m_, bj_, n_) (L + (ai_ * HALF + wr * 64 + m_ * 16 + fr) * 512 + ((bj_ * 32 + wc * 8 + n_ * 4 + fq + 4 * fr) & 63) * 8)
        if (kind == 2) {
            const int col0 = bcol + wc * 32 + fq * 4;
            f32x4 bv[2][2];
#pragma unroll
            for (int bj = 0; bj < 2; ++bj)
#pragma unroll
                for (int n = 0; n < 2; ++n) bv[bj][n] = *(const f32x4*)(bias + col0 + bj * HALF + n * 16);
#pragma unroll
            for (int ai = 0; ai < 2; ++ai)
#pragma unroll
                for (int m = 0; m < 4; ++m)
#pragma unroll
                    for (int bj = 0; bj < 2; ++bj)
#pragma unroll
                        for (int n = 0; n < 2; ++n) { const f32x4 v = acc[ai][bj][m][n]; float r[4];
#pragma unroll
                            for (int j = 0; j < 4; ++j) r[j] = sigmoidf_(v[j] + bv[bj][n][j]);
                            u32x2 o; o.x = pk2(r[0], r[1]); o.y = pk2(r[2], r[3]); *(u32x2*)EPI_SLOT(ai, m, bj, n) = o; }
            EPI_BAR; EPI_WIDE_STORE(T, ldt, trow0, tcol0); EPI_BAR;
            return;
        }
        if (kind == 3) {
            EPI_WIDE_LOAD(T, ldt, trow0, tcol0); EPI_BAR;
#pragma unroll
            for (int ai = 0; ai < 2; ++ai)
#pragma unroll
                for (int m = 0; m < 4; ++m)
#pragma unroll
                    for (int bj = 0; bj < 2; ++bj)
#pragma unroll
                        for (int n = 0; n < 2; ++n) { const u32x2 t = *(const u32x2*)EPI_SLOT(ai, m, bj, n); const f32x4 v = acc[ai][bj][m][n];
                            u32x2 o; o.x = pk2(v[0] * bflo(t.x), v[1] * bfhi(t.x)); o.y = pk2(v[2] * bflo(t.y), v[3] * bfhi(t.y)); *(u32x2*)EPI_SLOT(ai, m, bj, n) = o; }
            EPI_BAR; EPI_WIDE_STORE(T, ldt, trow0, tcol0); EPI_BAR;
            return;
        }
#pragma unroll 1
        for (int ai = 0; ai < 2; ++ai) {
#pragma unroll 1
            for (int k2 = 0; k2 < 8; k2 += 2)
#pragma unroll
                for (int k = k2; k < k2 + 2; ++k) { const int pp = tid + 512 * k, row = pp >> 5, pc = pp & 31, slot = (2 * pc + 4 * (row & 15)) & 63; const int grow = brow + ai * HALF + row;
                    *(u32x4*)(L + row * 512 + slot * 8) = *(const u32x4*)(T + (size_t)(grow - trow0) * ldt + (bcol + pc * 8 - tcol0));
                    *(u32x4*)(L + 65536 + row * 512 + slot * 8) = *(const u32x4*)(S1 + (size_t)grow * ldc + bcol + pc * 8); }
            EPI_BAR;
#pragma unroll
            for (int m = 0; m < 4; ++m)
#pragma unroll
                for (int bj = 0; bj < 2; ++bj)
#pragma unroll
                    for (int n = 0; n < 2; ++n) { unsigned char* sl = L + (wr * 64 + m * 16 + fr) * 512 + ((bj * 32 + wc * 8 + n * 4 + fq + 4 * fr) & 63) * 8;
                        const u32x2 t = *(const u32x2*)sl, s1 = *(const u32x2*)(sl + 65536); const f32x4 v = ai == 0 ? acc[0][bj][m][n] : acc[1][bj][m][n];
                        u32x2 o; o.x = pk2(bflo(s1.x) + v[0] * bflo(t.x), bfhi(s1.x) + v[1] * bfhi(t.x)); o.y = pk2(bflo(s1.y) + v[2] * bflo(t.y), bfhi(s1.y) + v[3] * bfhi(t.y)); *(u32x2*)sl = o; }
            EPI_BAR;
#pragma unroll 1
            for (int k2 = 0; k2 < 8; k2 += 2)
#pragma unroll
                for (int k = k2; k < k2 + 2; ++k) { const int pp = tid + 512 * k, row = pp >> 5, pc = pp & 31, slot = (2 * pc + 4 * (row & 15)) & 63;
                    *(u32x4*)(O + (size_t)(brow + ai * HALF + row) * ldc + bcol + pc * 8) = *(const u32x4*)(L + row * 512 + slot * 8); }
            EPI_BAR;
        }
#undef EPI_BAR
#undef EPI_WIDE_LOAD
#undef EPI_WIDE_STORE
#undef EPI_SLOT
    }
};
DI void gemm_job(const Params& p, int job) {
    unsigned char* ws = p.ws;
    const bf16_t* A = nullptr; const bf16_t* Bt = nullptr; int N = 1024, K = 1024, npass = 1;
    EpiAny e; e.kind = 0; e.O = nullptr; e.ldc = DM; e.ncols = DM; e.T = nullptr; e.ldt = DM; e.trow0 = 0; e.tcol0 = 0; e.bias = p.b_gate; e.S1 = nullptr;
    if (job == 0)      { A = (const bf16_t*)(ws + WS_H);      Bt = (const bf16_t*)(ws + WS_WFFN1GU); N = 5632; K = 1024; e.kind = 1; e.O = (bf16_t*)(ws + WS_HFF1); }
    else if (job == 1) { A = (const bf16_t*)(ws + WS_HFF1);   Bt = (const bf16_t*)(ws + WS_WFFN1D);  N = 1024; K = 2816; e.O = (bf16_t*)(ws + WS_F1); }
    else if (job == 2) { A = (const bf16_t*)(ws + WS_H);      Bt = (const bf16_t*)(ws + WS_WIN);     N = NPCPAD; K = 1024; e.O = (bf16_t*)(ws + WS_P); e.ldc = NPC; e.ncols = NPC; }
    else if (job == 3) { N = 1024; npass = 4; e.O = (bf16_t*)(ws + WS_MERGED); e.S1 = (const bf16_t*)(ws + WS_MERGED); }
    else if (job == 4) { A = (const bf16_t*)(ws + WS_MERGED); Bt = (const bf16_t*)(ws + WS_WOUT);    N = 1024; K = 1024; e.O = (bf16_t*)(ws + WS_O); }
    else if (job == 5) { A = (const bf16_t*)(ws + WS_H3);     Bt = (const bf16_t*)(ws + WS_WFFN2GU); N = 5632; K = 1024; e.kind = 1; e.O = (bf16_t*)(ws + WS_HFF2); }
    else               { A = (const bf16_t*)(ws + WS_HFF2);   Bt = (const bf16_t*)(ws + WS_WFFN2D);  N = 1024; K = 2816; e.O = (bf16_t*)(ws + WS_F2); }
    const int nM = MTOK / BM, nN = N / BM;
    const bf16_t* H2 = (const bf16_t*)(ws + WS_H2B); const bf16_t* WGp = (const bf16_t*)(ws + WS_WG);
#define GDESC(q_, ok_, A_, Bt_, K_, brow_, bcol_, ps_) do { const int _i = (q_) / npass; ps_ = (q_) - _i * npass; int _pm, _pn; ok_ = tile_order(nM, nN, _i, gridDim.x, blockIdx.x, _pm, _pn); \
        brow_ = _pm * BM; bcol_ = _pn * BM; \
        if (job == 3) { A_ = (ps_ == 0 || ps_ == 2) ? H2 : (ps_ == 1 ? (const bf16_t*)(ws + WS_YA) : (const bf16_t*)(ws + WS_QB)); \
            Bt_ = ps_ == 0 ? WGp : (ps_ == 2 ? WGp + 1024ull * 1024 : (ps_ == 1 ? (const bf16_t*)(ws + WS_WA) : (const bf16_t*)(ws + WS_WB))); K_ = (ps_ & 1) ? 512 : 1024; } \
        else { A_ = A; Bt_ = Bt; K_ = K; } } while (0)
    bool ok, okn; const bf16_t* Ac; const bf16_t* Btc; int Kc, brow, bcol, ps; const bf16_t* An; const bf16_t* Btn; int Kn, brown, bcoln, psn;
    GDESC(0, ok, Ac, Btc, Kc, brow, bcol, ps);
    bool pre = false;
#pragma unroll 1
    for (int q = 0; ok; ++q) {
        GDESC(q + 1, okn, An, Btn, Kn, brown, bcoln, psn);
        if (job == 3) {
            const bool second = ps >= 2;
            e.kind = (ps == 0 || ps == 2) ? 2 : (ps == 1 ? 3 : 4);
            e.T = second ? (bf16_t*)(ws + WS_SCR) + (size_t)blockIdx.x * 65536 : (bf16_t*)(ws + WS_MERGED);
            e.ldt = second ? 256 : DM; e.trow0 = second ? brow : 0; e.tcol0 = second ? bcol : 0; e.bias = p.b_gate + (second ? 1024 : 0);
        }
        const bool hn = false;
        gemm_tile(Ac, Btc, Kc, brow, bcol, e, pre, hn, An, Btn, Kn, brown, bcoln);
        pre = hn; ok = okn; Ac = An; Btc = Btn; Kc = Kn; brow = brown; bcol = bcoln; ps = psn;
    }
#undef GDESC
}

DI void seq_of_token(int m, int& base, int& T, int& sq) { if (m < MPROMPT) { sq = m >> 13; base = sq << 13; T = TP; } else { const int s = (m - MPROMPT) >> 11; sq = 2 + s; base = MPROMPT + (s << 11); T = TS; } }
DI size_t vt_seq_off(int sq) { return sq < 2 ? (size_t)sq * 2 * 64 * TP : (size_t)2 * 2 * 64 * TP + (size_t)(sq - 2) * 2 * 64 * TS; }

DI void attn_prep_phase(const Params& p) {
    const int TID = tid_();
    const bf16_t* P = (const bf16_t*)(p.ws + WS_P);
    bf16_t* QB = (bf16_t*)(p.ws + WS_QB); bf16_t* KB = (bf16_t*)(p.ws + WS_KB); bf16_t* VT = (bf16_t*)(p.ws + WS_VT);
    const int wave = TID >> 6, lane = TID & 63, gw = blockIdx.x * 8 + wave, ngw = gridDim.x * 8;
    const int part = lane & 7, hsel = lane >> 3;
    float invf[4], gq[8], gk[8];
#pragma unroll
    for (int j = 0; j < 4; ++j) invf[j] = exp2f(-(float)((((part & 3) * 4 + j)) * 2) * (13.287712379549449f / 32.f)) * 0.15915494309189535f;
#pragma unroll
    for (int i = 0; i < 8; ++i) { gq[i] = p.qk_g[part * 8 + i]; gk[i] = p.qk_g[64 + part * 8 + i]; }
    for (int m4 = gw * 4; m4 < MTOK; m4 += ngw * 4) {
#pragma unroll
        for (int sub = 0; sub < 5; ++sub) {
            const bool isq = sub < 4;
            const int m = isq ? m4 + sub : m4 + (hsel >> 1), hd = isq ? hsel : (hsel & 1);
            int base, T, sq; seq_of_token(m, base, T, sq); const int t = m - base;
            const float pos = (part < 4) ? (float)(t >> 6) : (float)(t & 63);
            float x[8]; unpack8(*(const u32x4*)(P + (size_t)m * NPC + (isq ? 1920 : 2432) + hd * 64 + part * 8), x);
            float ss = 0.f;
#pragma unroll
            for (int i = 0; i < 8; ++i) ss += x[i] * x[i];
            ss = sum8_dpp(ss);
            const float rs = rsqrtf(ss * (1.f / 64.f) + 1e-6f);
            const float sc = isq ? 0.125f * 1.4426950408889634f : 1.f;
            float o[8];
#pragma unroll
            for (int j = 0; j < 4; ++j) {
                float rev = pos * invf[j]; rev -= rintf(rev);
                const float sn = __builtin_amdgcn_sinf(rev), cs = __builtin_amdgcn_cosf(rev);
                const float x0 = x[2 * j] * rs * (isq ? gq[2 * j] : gk[2 * j]), x1 = x[2 * j + 1] * rs * (isq ? gq[2 * j + 1] : gk[2 * j + 1]);
                o[2 * j] = (x0 * cs - x1 * sn) * sc; o[2 * j + 1] = (x0 * sn + x1 * cs) * sc;
            }
            bf16_t* dst = isq ? QB + (size_t)m * 512 + hd * 64 + part * 8 : KB + (size_t)m * 128 + hd * 64 + part * 8;
            *(u32x4*)dst = pack8(o);
        }
    }
    bf16_t* L = (bf16_t*)smem;
    for (int it = blockIdx.x; it < MTOK / 64; it += gridDim.x) {
        const int m0 = it * 64; int base, T, sq; seq_of_token(m0, base, T, sq); const int t0 = m0 - base;
        { const int t = TID >> 3, cgp = TID & 7; const bf16_t* src = P + (size_t)(m0 + t) * NPC + 2560 + cgp * 16;
          const u32x4 a = *(const u32x4*)src, b = *(const u32x4*)(src + 8);
          *(u32x4*)(L + t * 136 + cgp * 16) = a; *(u32x4*)(L + t * 136 + cgp * 16 + 8) = b; }
        __syncthreads();
        { const int dcol = TID >> 2, tq = TID & 3; float f[16];
#pragma unroll
          for (int i = 0; i < 16; ++i) f[i] = bf2f(L[(tq * 16 + i) * 136 + dcol]);
          bf16_t* dst = VT + vt_seq_off(sq) + ((size_t)(dcol >> 6) * 64 + (dcol & 63)) * T + t0 + tq * 16;
          *(u32x4*)dst = pack8(f); *(u32x4*)(dst + 8) = pack8(f + 8); }
        __syncthreads();
    }
}

DI void attn_item(const Params& p, int sq, int hq, int qb) {
    const int TID = tid_();
    bf16_t* QB = (bf16_t*)(p.ws + WS_QB); const bf16_t* KB = (const bf16_t*)(p.ws + WS_KB); const bf16_t* VT = (const bf16_t*)(p.ws + WS_VT);
    const int T = sq < 2 ? TP : TS, base = sq < 2 ? sq * TP : MPROMPT + (sq - 2) * TS, hk = hq >> 2;
    const int wave = __builtin_amdgcn_readfirstlane(TID >> 6), lane = TID & 63, r = lane & 31, h = lane >> 5;
    bf16_t* LK = (bf16_t*)smem;
    bf16_t* LV = LK + 2 * 64 * 72;
    const int mq = base + qb * 512 + wave * 64 + r;
    bf16x8 qf[2][4];
#pragma unroll
    for (int qq = 0; qq < 2; ++qq)
#pragma unroll
        for (int s = 0; s < 4; ++s) qf[qq][s] = *(const bf16x8*)(QB + (size_t)(mq + 32 * qq) * 512 + hq * 64 + 16 * s + 8 * h);
    const bf16_t* kg = KB + (size_t)base * 128 + hk * 64;
    const bf16_t* vg = VT + vt_seq_off(sq) + (size_t)hk * 64 * T;
    const int lr = TID >> 3, lc = (TID & 7) * 8;
    f32x16 oacc[2][2];
#pragma unroll
    for (int qq = 0; qq < 2; ++qq) for (int i = 0; i < 16; ++i) { oacc[qq][0][i] = 0.f; oacc[qq][1][i] = 0.f; }
    float mrun[2] = {0.f, 0.f}, lrun[2] = {0.f, 0.f}; bool shifted = false;
    const int nt = T / 64;
    u32x4 kreg = *(const u32x4*)(kg + (size_t)lr * 128 + lc), vreg = *(const u32x4*)(vg + (size_t)lr * T + lc);
    *(u32x4*)(LK + lr * 72 + lc) = kreg; *(u32x4*)(LV + lr * 72 + lc) = vreg;
    __syncthreads();
    for (int t = 0; t < nt; ++t) {
        const int cur = t & 1;
        if (t + 1 < nt) { kreg = *(const u32x4*)(kg + (size_t)((t + 1) * 64 + lr) * 128 + lc); vreg = *(const u32x4*)(vg + (size_t)lr * T + (t + 1) * 64 + lc); }
        const bf16_t* lk = LK + cur * 64 * 72; const bf16_t* lv = LV + cur * 64 * 72;
        f32x16 sc[2][2];
#pragma unroll
        for (int kb = 0; kb < 2; ++kb) { for (int i = 0; i < 16; ++i) { sc[0][kb][i] = 0.f; sc[1][kb][i] = 0.f; }
#pragma unroll
            for (int s = 0; s < 4; ++s) { const bf16x8 kf = *(const bf16x8*)(lk + (kb * 32 + r) * 72 + 16 * s + 8 * h);
                sc[0][kb] = MFMA32(kf, qf[0][s], sc[0][kb]); sc[1][kb] = MFMA32(kf, qf[1][s], sc[1][kb]); } }
        float mx[2];
#pragma unroll
        for (int qq = 0; qq < 2; ++qq) { float m = sc[qq][0][0];
#pragma unroll
            for (int i = 0; i < 16; ++i) { m = fmaxf(m, sc[qq][0][i]); m = fmaxf(m, sc[qq][1][i]); }
            { const u32x2 sw = __builtin_amdgcn_permlane32_swap(__float_as_uint(m), __float_as_uint(m), false, false);
              mx[qq] = fmaxf(__uint_as_float(sw.x), __uint_as_float(sw.y)); } }
        const float dm0 = mx[0] - mrun[0], dm1 = mx[1] - mrun[1];
        if (__builtin_amdgcn_ballot_w64(dm0 > 24.f || dm1 > 24.f || (t == 0 && (dm0 < -24.f || dm1 < -24.f))) != 0ull) {
            shifted = true;
#pragma unroll
            for (int qq = 0; qq < 2; ++qq) {
                const float mnew = (t == 0) ? mx[qq] : fmaxf(mrun[qq], mx[qq]), alpha = (t == 0) ? 1.f : __builtin_amdgcn_exp2f(mrun[qq] - mnew);
                mrun[qq] = mnew; lrun[qq] *= alpha;
#pragma unroll
                for (int i = 0; i < 16; ++i) { oacc[qq][0][i] *= alpha; oacc[qq][1][i] *= alpha; } }
        }
        if (shifted) {
#pragma unroll
            for (int qq = 0; qq < 2; ++qq)
#pragma unroll
                for (int kb = 0; kb < 2; ++kb)
#pragma unroll
                    for (int i = 0; i < 16; ++i) sc[qq][kb][i] -= mrun[qq];
        }
#pragma unroll
        for (int qq = 0; qq < 2; ++qq) { float ps = 0.f;
#pragma unroll
            for (int kb = 0; kb < 2; ++kb)
#pragma unroll
                for (int i = 0; i < 16; ++i) { const float e = __builtin_amdgcn_exp2f(sc[qq][kb][i]); sc[qq][kb][i] = e; ps += e; }
            lrun[qq] += ps; }
#pragma unroll
        for (int s2 = 0; s2 < 4; ++s2) {
            const bf16x8 pb0 = pack_step(sc[0][s2 >> 1], s2 & 1), pb1 = pack_step(sc[1][s2 >> 1], s2 & 1);
#pragma unroll
            for (int db = 0; db < 2; ++db) {
                const bf16_t* vp = lv + (db * 32 + r) * 72 + 16 * s2 + 4 * h;
                const s16x4 lo = *(const s16x4*)vp, hi = *(const s16x4*)(vp + 8);
                const bf16x8 vf = __builtin_shufflevector(lo, hi, 0, 1, 2, 3, 4, 5, 6, 7);
                oacc[0][db] = MFMA32(vf, pb0, oacc[0][db]); oacc[1][db] = MFMA32(vf, pb1, oacc[1][db]);
            }
        }
        if (t + 1 < nt) { *(u32x4*)(LK + (cur ^ 1) * 64 * 72 + lr * 72 + lc) = kreg; *(u32x4*)(LV + (cur ^ 1) * 64 * 72 + lr * 72 + lc) = vreg; }
        __syncthreads();
    }
#pragma unroll
    for (int qq = 0; qq < 2; ++qq) {
        float l = lrun[qq]; l += __shfl_xor(l, 32);
        const float inv = 1.f / l;
        bf16_t* op = QB + (size_t)(mq + 32 * qq) * 512 + hq * 64;
#pragma unroll
        for (int db = 0; db < 2; ++db)
#pragma unroll
            for (int g = 0; g < 4; ++g) { u32x2 o; o.x = pk2(oacc[qq][db][4 * g] * inv, oacc[qq][db][4 * g + 1] * inv); o.y = pk2(oacc[qq][db][4 * g + 2] * inv, oacc[qq][db][4 * g + 3] * inv);
                *(u32x2*)(op + db * 32 + 8 * g + 4 * h) = o; }
    }
}
DI void attn_phase(const Params& p) {
    for (int it = blockIdx.x; it < 768; it += gridDim.x) {
        if (it < 256) { attn_item(p, it >> 7, (it >> 4) & 7, it & 15); }
        else { const int j = it - 256; attn_item(p, 2 + (j >> 5), (j >> 2) & 7, j & 3); }
    }
}

struct ScanItem { int d, h, T, tokbase, seg, nseg; };
DI ScanItem scan_item(int it) {
    ScanItem s;
    if (it < 512) { const int sc = it >> 4; s.seg = it & 15; s.nseg = 16; s.d = sc >> 4; s.h = sc & 7; s.T = TP; s.tokbase = ((sc >> 3) & 1) * TP; }
    else { const int j = it - 512, sc = j >> 3; s.seg = j & 7; s.nseg = 8; s.d = sc >> 7; s.h = sc & 7; s.T = TS; s.tokbase = MPROMPT + ((sc >> 3) & 15) * TS; }
    return s;
}
constexpr int P72 = 72, P40 = 40, PF = 68;
constexpr int RAW_B = 25600;
constexpr int O_RAW = 0, O_RT = RAW_B, O_KA = O_RT + 4608, O_KT = O_KA + 4608, O_BT = O_KT + 4608, O_KHT = O_BT + 4608, O_BHT = O_KHT + 5120, O_VTL = O_BHT + 5120,
              O_TW = O_KHT, O_AD = O_BHT,
              O_GAM = O_VTL + 5120, O_WTOT = O_GAM + 256, O_CONST = O_WTOT + 1024, O_U0 = O_CONST + 2560, O_WPRE = O_U0, O_APRE = O_U0 + 8704,
              O_APOW = O_U0, O_AAK = O_U0 + 5120, O_ARK = O_U0 + 7680, O_ARB = O_U0 + 10240, O_WM = O_U0 + 12800, GRP_LDS = O_U0 + 17408;
static_assert(GRP_LDS % 16 == 0 && 2 * GRP_LDS + 16 <= 160 * 1024, "LDS budget");
#define RBAR do { asm volatile("s_waitcnt lgkmcnt(0)" ::: "memory"); __builtin_amdgcn_s_barrier(); asm volatile("" ::: "memory"); } while (0)
DI bf16x8 lds_nat(const bf16_t* base, int row, int pitch, int s, int hh) { return *(const bf16x8*)(base + row * pitch + 16 * s + 8 * hh); }
DI bf16x8 lds_perm(const bf16_t* base, int row, int pitch, int s, int hh) {
    const bf16_t* q = base + row * pitch + 16 * s + 4 * hh; const s16x4 lo = *(const s16x4*)q, hi = *(const s16x4*)(q + 8);
    return __builtin_shufflevector(lo, hi, 0, 1, 2, 3, 4, 5, 6, 7);
}
DI bf16x8 lds_nat_sw(const bf16_t* base, int row, int s, int hh) { const int x = (row >> 3) & 3; return *(const bf16x8*)(base + row * P40 + (((2 * s + hh) ^ x) << 3)); }
DI bf16x8 lds_perm_sw(const bf16_t* base, int row, int s, int hh) {
    const int x = (row >> 3) & 3; const bf16_t* q = base + row * P40 + 4 * hh; const s16x4 lo = *(const s16x4*)(q + (((2 * s) ^ x) << 3)), hi = *(const s16x4*)(q + (((2 * s + 1) ^ x) << 3));
    return __builtin_shufflevector(lo, hi, 0, 1, 2, 3, 4, 5, 6, 7);
}
DI void load_shift8(const bf16_t* P, const float* mu, int m, int col, bool hp, bool hn, float* x) {
    const bf16_t* q = P + (size_t)m * NPC + col;
    float a[8], b[8], c[8]; unpack8(*(const u32x4*)q, a);
    const u32x4 z = {0u, 0u, 0u, 0u};
    unpack8(hp ? *(const u32x4*)(q - NPC) : z, b); unpack8(hn ? *(const u32x4*)(q + NPC) : z, c);
    const f32x4 m0 = *(const f32x4*)(mu + col), m1 = *(const f32x4*)(mu + col + 4);
#pragma unroll
    for (int i = 0; i < 8; ++i) { const float mm = i < 4 ? m0[i & 3] : m1[i & 3]; x[i] = a[i] + (0.5f * (b[i] + c[i]) - a[i]) * mm; }
}

DI void rwkv_prefetch(const bf16_t* P, unsigned char* RAWL, const ScanItem& si, int tau0, int gw, int lane) {
    int ln = lane; asm volatile("" : "+v"(ln));
    const int r8 = ln >> 3, sub = ln & 7;
#pragma unroll
    for (int r = 0; r < 7; ++r) {
        int inst = r * 4 + gw; inst = inst > 24 ? 24 : inst;
        const int cg = inst / 5, rb = inst - cg * 5;
        int tau = tau0 - 1 + rb * 8 + r8; tau = tau < 0 ? 0 : (tau > si.T - 1 ? si.T - 1 : tau);
        const int tok = si.d ? si.T - 1 - tau : tau;
        const int colb = (cg < 3 ? cg * 512 + si.h * 64 : (cg == 3 ? 1536 : 1664) + si.d * 64);
        __builtin_amdgcn_global_load_lds((const unsigned*)(P + (size_t)(si.tokbase + tok) * NPC + colb + sub * 8), (unsigned*)(RAWL + inst * 1024), 16, 0, 0);
    }
}

DI void rwkv_pass(const Params& p, const int PASS) {
    const int TID = tid_();
    const bf16_t* P = (const bf16_t*)(p.ws + WS_P);
    float* NB = (float*)(p.ws + WS_NBUF); float* PB = (float*)(p.ws + WS_PBUF);
    bf16_t* YD = (bf16_t*)(p.ws + WS_YDIR); float* COEF = (float*)(p.ws + WS_COEF);
    const bf16_t* WUPT = (const bf16_t*)(p.ws + WS_WUPT); const bf16_t* AUPT = (const bf16_t*)(p.ws + WS_AUPT);
    const int wave = __builtin_amdgcn_readfirstlane(TID >> 6), lane = TID & 63, grp = wave >> 2, pw = wave & 3, gw = (pw + 2 * grp) & 3, gtid = TID & 255;
    const int c = lane & 31, hh = lane >> 5;
    unsigned char* L = smem + grp * GRP_LDS;
    bf16_t* TW = (bf16_t*)(L + O_TW); bf16_t* AD = (bf16_t*)(L + O_AD); bf16_t* RT = (bf16_t*)(L + O_RT); bf16_t* KA = (bf16_t*)(L + O_KA);
    bf16_t* KT = (bf16_t*)(L + O_KT); bf16_t* BT = (bf16_t*)(L + O_BT); bf16_t* KHT = (bf16_t*)(L + O_KHT); bf16_t* BHT = (bf16_t*)(L + O_BHT);
    bf16_t* VTL = (bf16_t*)(L + O_VTL); float* GAM = (float*)(L + O_GAM); float* WTOT = (float*)(L + O_WTOT);
    float* CONSTL = (float*)(L + O_CONST); unsigned char* RAWL = L + O_RAW;
    float* WPRE = (float*)(L + O_WPRE); float* APRE = (float*)(L + O_APRE);
    bf16_t* APOW = (bf16_t*)(L + O_APOW); bf16_t* AAK = (bf16_t*)(L + O_AAK); bf16_t* ARK = (bf16_t*)(L + O_ARK); bf16_t* ARB = (bf16_t*)(L + O_ARB); bf16_t* WM = (bf16_t*)(L + O_WM);
    const int et = gtid >> 3, jg = gtid & 7;
    const int etsw = ((((et >> 3) ^ (jg & 3))) << 3) | (et & 7);
    const bool isS = gw >= 2; const int tile = gw & 1;

    for (int pair = blockIdx.x; pair < 1280; pair += gridDim.x) {
        const int item = pair * 2 + grp; const ScanItem si = scan_item(item);
        const int hj = si.h * 64 + jg * 8;
        for (int q = gtid; q < 640; q += 256) {
            const int j = q & 63; float v;
            if (q < 320) { const int arr = q >> 6; const float* src = arr == 0 ? p.w0 + si.d * 512 : (arr == 1 ? p.a0 + si.d * 512 : (arr == 2 ? p.k_k : (arr == 3 ? p.k_a : p.r_k))); v = src[si.h * 64 + j]; }
            else { const int cg = (q - 320) >> 6; v = p.mu[(cg < 3 ? cg * 512 + si.h * 64 : (cg == 3 ? 1536 : 1664) + si.d * 64) + j]; }
            CONSTL[q] = v; }
        const int nch = si.nseg == 16 ? 16 : 8;
        rwkv_prefetch(P, RAWL, si, si.seg * nch * 32, gw, lane);
        f32x16 XT[2];
#pragma unroll
        for (int jt = 0; jt < 2; ++jt)
#pragma unroll
            for (int i = 0; i < 16; ++i) XT[jt][i] = 0.f;
        int lnI = lane; asm volatile("" : "+v"(lnI)); const int cI = lnI & 31, hhI = lnI >> 5;
        const int idc_ = 32 * tile + cI - 4 * hhI;
        if (PASS == 0) { if (!isS) {
#pragma unroll
            for (int jt = 0; jt < 2; ++jt)
#pragma unroll
                for (int i = 0; i < 16; ++i) XT[jt][i] = (32 * jt + crow(i, 0) == idc_) ? 1.f : 0.f; } }
        else { if (isS && si.seg > 0) { const int lo_ = 4 * hhI * 64 + 32 * tile + cI; const float* src = NB + (size_t)(item - 1) * 4096 + lo_;
#pragma unroll
            for (int jt = 0; jt < 2; ++jt)
#pragma unroll
                for (int i = 0; i < 16; ++i) XT[jt][i] = src[(32 * jt + crow(i, 0)) * 64]; } }

#pragma unroll 1
        for (int ch = 0; ch < nch; ++ch) {
            const int tau0 = si.seg * nch * 32 + ch * 32;
            asm volatile("s_waitcnt vmcnt(0)" ::: "memory");
            RBAR;
            float rr[8], kx[8], vv[8];
            bf16x8 bfr[4];
            { int lnC = lane; asm volatile("" : "+v"(lnC));
              const bf16_t* up = ((gw >> 1) ? AUPT : WUPT) + ((size_t)(si.d * 512 + si.h * 64 + 32 * (gw & 1) + (lnC & 31))) * 64 + 8 * (lnC >> 5);
#pragma unroll
              for (int s = 0; s < 4; ++s) bfr[s] = *(const bf16x8*)(up + 16 * s); }
            { const int tau = tau0 + et; const bool vlo = tau > 0, vhi = tau < si.T - 1;
              int lnS = lane; asm volatile("" : "+v"(lnS));
              float wd[8], ad[8];
#pragma unroll
              for (int cg = 0; cg < 5; ++cg) {
                  const int etc = pw * 8 + (lnS >> 3), jgc = lnS & 7;
                  const int r0 = etc, r1 = etc + 1, r2 = etc + 2;
                  const unsigned char* qb = RAWL + (cg * 5 * 64 + jgc) * 16;
                  const unsigned char* q0 = qb + ((r0 >> 3) * 64 + (r0 & 7) * 8) * 16; const unsigned char* q = qb + ((r1 >> 3) * 64 + (r1 & 7) * 8) * 16; const unsigned char* q2 = qb + ((r2 >> 3) * 64 + (r2 & 7) * 8) * 16;
                  const u32x4 z4 = {0u, 0u, 0u, 0u};
                  float a[8], b[8], cc[8]; unpack8(*(const u32x4*)q, a); unpack8(vlo ? *(const u32x4*)q0 : z4, b); unpack8(vhi ? *(const u32x4*)q2 : z4, cc);
                  const f32x4 m0 = *(const f32x4*)(CONSTL + 320 + cg * 64 + jg * 8), m1 = *(const f32x4*)(CONSTL + 320 + cg * 64 + jg * 8 + 4);
                  float* x = cg == 0 ? rr : (cg == 1 ? kx : (cg == 2 ? vv : (cg == 3 ? wd : ad)));
#pragma unroll
                  for (int i = 0; i < 8; ++i) { const float mm = i < 4 ? m0[i & 3] : m1[i & 3]; x[i] = a[i] + (0.5f * (b[i] + cc[i]) - a[i]) * mm; }
              }
#pragma unroll
              for (int i = 0; i < 8; ++i) wd[i] = tanhf_(wd[i]);
              *(u32x4*)(TW + et * P72 + jg * 8) = pack8(wd); *(u32x4*)(AD + et * P72 + jg * 8) = pack8(ad); }
            asm volatile("" :: "v"(bfr[0]), "v"(bfr[1]), "v"(bfr[2]), "v"(bfr[3]));
            RBAR;
            rwkv_prefetch(P, RAWL, si, tau0 + 32, gw, lane);
            { f32x16 acc; for (int i = 0; i < 16; ++i) acc[i] = 0.f;
              const bf16_t* Asrc = (gw >> 1) ? AD : TW;
#pragma unroll
              for (int s = 0; s < 4; ++s) acc = MFMA32(lds_nat(Asrc, c, P72, s, hh), bfr[s], acc);
              float* dst = ((gw >> 1) ? APRE : WPRE) + 32 * (gw & 1) + c;
#pragma unroll
              for (int i = 0; i < 16; ++i) dst[crow(i, hh) * PF] = acc[i]; }
            RBAR;
            { float cl[8], lw[8], av[8], kk[8], kd[8];
#pragma unroll
              for (int i = 0; i < 8; ++i) VTL[(jg * 8 + i) * P40 + etsw] = f2bf(vv[i]);
              float ss = 0.f, cf = 0.f;
              { const f32x4 wp0 = *(const f32x4*)(WPRE + et * PF + jg * 8), wp1 = *(const f32x4*)(WPRE + et * PF + jg * 8 + 4);
                const f32x4 ap0 = *(const f32x4*)(APRE + et * PF + jg * 8), ap1 = *(const f32x4*)(APRE + et * PF + jg * 8 + 4);
#pragma unroll
                for (int i = 0; i < 8; ++i) {
                  const float wpre = (i < 4 ? wp0[i & 3] : wp1[i & 3]) + CONSTL[jg * 8 + i];
                  const float apre = (i < 4 ? ap0[i & 3] : ap1[i & 3]) + CONSTL[64 + jg * 8 + i];
                  lw[i] = -0.60653065971263342f * sigmoidf_(wpre);
                  av[i] = sigmoidf_(apre);
                  kk[i] = kx[i] * CONSTL[128 + jg * 8 + i]; ss += kk[i] * kk[i];
                  kd[i] = kx[i] * (1.f + (av[i] - 1.f) * CONSTL[192 + jg * 8 + i]);
                  cf += rr[i] * kd[i] * CONSTL[256 + jg * 8 + i];
                } }
              ss = sum8_dpp(ss);
              const float inv = __builtin_amdgcn_rsqf(fmaxf(ss, 1e-24f));
              if (PASS == 1) { cf = sum8_dpp(cf);
                  if (jg == 0) { const int tau = tau0 + et, tok = si.d ? si.T - 1 - tau : tau; COEF[((size_t)si.d * MTOK + si.tokbase + tok) * 8 + si.h] = cf; } }
#pragma unroll
              for (int i = 0; i < 8; ++i) { kk[i] *= inv; cl[i] = lw[i]; }
#pragma unroll
              for (int dlt = 8; dlt < 64; dlt <<= 1) {
#pragma unroll
                  for (int i = 0; i < 8; ++i) { const float o = __shfl_up(cl[i], dlt); if (lane >= dlt) cl[i] += o; } }
              if (lane >= 56) {
#pragma unroll
                  for (int i = 0; i < 8; ++i) WTOT[pw * 64 + jg * 8 + i] = cl[i]; }
              RBAR;
              float tot[8];
#pragma unroll
              for (int i = 0; i < 8; ++i) { float pre = 0.f, t4 = 0.f;
#pragma unroll
                  for (int w = 0; w < 4; ++w) { const float x = WTOT[w * 64 + jg * 8 + i]; t4 += x; if (w < pw) pre += x; }
                  cl[i] += pre; tot[i] = t4; }
              { float o[8];
                if (PASS == 1) {
#pragma unroll
                    for (int i = 0; i < 8; ++i) o[i] = rr[i] * __expf(cl[i]);
                    *(u32x4*)(RT + et * P72 + jg * 8) = pack8(o); }
#pragma unroll
                for (int i = 0; i < 8; ++i) o[i] = kk[i] * __expf(cl[i] - lw[i]);
                *(u32x4*)(KA + et * P72 + jg * 8) = pack8(o); }
              { float en[8], o[8];
#pragma unroll
                for (int i = 0; i < 8; ++i) { en[i] = __expf(-cl[i]); o[i] = kd[i] * en[i]; }
                *(u32x4*)(KT + et * P72 + jg * 8) = pack8(o);
#pragma unroll
                for (int i = 0; i < 8; ++i) o[i] = kk[i] * av[i] * en[i];
                *(u32x4*)(BT + et * P72 + jg * 8) = pack8(o); }
#pragma unroll
              for (int i = 0; i < 8; ++i) { const float eh = __expf(tot[i] - cl[i]);
                  KHT[(jg * 8 + i) * P40 + etsw] = f2bf(kd[i] * eh); BHT[(jg * 8 + i) * P40 + etsw] = f2bf(kk[i] * av[i] * eh); }
              if (et == 0) {
#pragma unroll
                  for (int i = 0; i < 8; ++i) GAM[jg * 8 + i] = __expf(tot[i]); }
            }
            RBAR;
            f32x16 apw;
            if (PASS == 1 || gw < 2) { const bf16_t* Am = (gw < 2) ? KA : RT; const bf16_t* Bm = (gw == 0 || gw == 3) ? BT : KT;
              f32x16 acc; for (int i = 0; i < 16; ++i) acc[i] = 0.f;
#pragma unroll
              for (int s = 0; s < 4; ++s) acc = MFMA32(lds_nat(Am, c, P72, s, hh), lds_nat(Bm, c, P72, s, hh), acc);
              bf16_t* dst = gw == 0 ? APOW : (gw == 1 ? AAK : (gw == 2 ? ARK : ARB));
#pragma unroll
              for (int i = 0; i < 16; ++i) { const int t = crow(i, hh); const bool keep = (gw < 2) ? (c < t) : (c <= t); acc[i] = keep ? acc[i] : 0.f; dst[t * P40 + c] = f2bf(acc[i]); }
              apw = acc; }
            RBAR;
            f32x16 rhs;
            if (gw < 2) {
#pragma unroll
                for (int i = 0; i < 16; ++i) rhs[i] = bf2f(KA[crow(i, hh) * P72 + 32 * gw + c]);
            } else { for (int i = 0; i < 16; ++i) rhs[i] = 0.f;
#pragma unroll
                for (int s2 = 0; s2 < 2; ++s2) rhs = MFMA32(lds_nat(AAK, c, P40, s2, hh), lds_nat_sw(VTL, 32 * tile + c, s2, hh), rhs);
#pragma unroll
                for (int i = 0; i < 16; ++i) rhs[i] = -rhs[i]; }
#pragma unroll
            for (int k = 0; k < 5; ++k) {
                const bf16_t* Ap = APOW + (k & 1) * 32 * P40;
                f32x16 dl; for (int i = 0; i < 16; ++i) dl[i] = 0.f;
#pragma unroll
                for (int s2 = 0; s2 < 2; ++s2) dl = MFMA32(lds_perm(Ap, c, P40, s2, hh), pack_step(rhs, s2), dl);
                if (k == 0) { for (int i = 0; i < 16; ++i) rhs[i] -= dl[i]; } else { for (int i = 0; i < 16; ++i) rhs[i] += dl[i]; }
                if (k < 4 && gw == 0) {
                    f32x16 nx; for (int i = 0; i < 16; ++i) nx[i] = 0.f;
#pragma unroll
                    for (int s2 = 0; s2 < 2; ++s2) nx = MFMA32(lds_perm(Ap, c, P40, s2, hh), pack_step(apw, s2), nx);
                    bf16_t* An = APOW + ((k + 1) & 1) * 32 * P40;
#pragma unroll
                    for (int i = 0; i < 16; ++i) An[crow(i, hh) * P40 + c] = f2bf(nx[i]);
                    apw = nx;
                }
                RBAR;
            }
            if (gw < 2) {
#pragma unroll
                for (int i = 0; i < 16; ++i) WM[crow(i, hh) * P72 + 32 * gw + c] = f2bf(rhs[i]); }
            RBAR;
            if (PASS == 0 || isS) {
                bf16x8 xb[4];
#pragma unroll
                for (int s = 0; s < 4; ++s) xb[s] = pack_step(XT[s >> 1], s & 1);
                f32x16 g; for (int i = 0; i < 16; ++i) g[i] = 0.f;
#pragma unroll
                for (int s = 0; s < 4; ++s) g = MFMA32(lds_perm(WM, c, P72, s, hh), xb[s], g);
                f32x16 z;
                if (isS) { for (int i = 0; i < 16; ++i) z[i] = rhs[i] - g[i]; } else { for (int i = 0; i < 16; ++i) z[i] = -g[i]; }
                bf16x8 zb[2]; zb[0] = pack_step(z, 0); zb[1] = pack_step(z, 1);
                bf16x8 vf[2];
                if (isS) { vf[0] = lds_nat_sw(VTL, 32 * tile + c, 0, hh); vf[1] = lds_nat_sw(VTL, 32 * tile + c, 1, hh); }
                if (PASS == 1) {
                    f32x16 y; for (int i = 0; i < 16; ++i) y[i] = 0.f;
#pragma unroll
                    for (int s = 0; s < 4; ++s) y = MFMA32(lds_perm(RT, c, P72, s, hh), xb[s], y);
#pragma unroll
                    for (int s2 = 0; s2 < 2; ++s2) { y = MFMA32(lds_nat(ARK, c, P40, s2, hh), vf[s2], y); y = MFMA32(lds_perm(ARB, c, P40, s2, hh), zb[s2], y); }
                    { const int tok0 = si.d ? si.T - 1 - tau0 - 4 * hh : tau0 + 4 * hh; const long rstride = si.d ? -512 : 512;
                      bf16_t* yp = YD + ((size_t)si.d * MTOK + si.tokbase + tok0) * 512 + si.h * 64 + 32 * tile + c;
#pragma unroll
                      for (int i = 0; i < 16; ++i) yp[rstride * crow(i, 0)] = f2bf(y[i]); }
                }
#pragma unroll
                for (int jt = 0; jt < 2; ++jt) {
                    f32x16 nx;
#pragma unroll
                    for (int g4 = 0; g4 < 4; ++g4) { const f32x4 gm = *(const f32x4*)(GAM + 32 * jt + 8 * g4 + 4 * hh);
#pragma unroll
                        for (int j = 0; j < 4; ++j) nx[4 * g4 + j] = XT[jt][4 * g4 + j] * gm[j]; }
#pragma unroll
                    for (int s2 = 0; s2 < 2; ++s2) {
                        nx = MFMA32(lds_perm_sw(BHT, 32 * jt + c, s2, hh), zb[s2], nx);
                        if (isS) nx = MFMA32(lds_nat_sw(KHT, 32 * jt + c, s2, hh), vf[s2], nx);
                    }
                    XT[jt] = nx;
                }
            }
        }
        if (PASS == 0) { int lnE = lane; asm volatile("" : "+v"(lnE)); const int lo_ = 4 * (lnE >> 5) * 64 + 32 * tile + (lnE & 31);
            if (isS) { float* dst = NB + (size_t)item * 4096 + lo_;
#pragma unroll
                for (int jt = 0; jt < 2; ++jt)
#pragma unroll
                    for (int i = 0; i < 16; ++i) dst[(32 * jt + crow(i, 0)) * 64] = XT[jt][i]; }
            else { bf16_t* dst = (bf16_t*)PB + (size_t)item * 4096 + lo_;
#pragma unroll
                for (int jt = 0; jt < 2; ++jt)
#pragma unroll
                    for (int i = 0; i < 16; ++i) dst[(32 * jt + crow(i, 0)) * 64] = f2bf(XT[jt][i]); } }
        RBAR;
    }
}

DI void rwkv_chain(const Params& p) {
    const int TID = tid_();
    float* NB = (float*)(p.ws + WS_NBUF); const bf16_t* PBh = (const bf16_t*)(p.ws + WS_PBUF);
    const int wave = TID >> 6, lane = TID & 63, c = lane & 31, hh = lane >> 5;
    const int G = gridDim.x; const bool split = G >= 128;
    int task0, tstep, tend;
    if (!split) { task0 = wave * G + blockIdx.x; tstep = G * 8; tend = 576; }
    else if ((int)blockIdx.x < 64) { task0 = wave == 0 ? (int)blockIdx.x : 576; tstep = 576; tend = 576; }
    else { task0 = 64 + ((int)blockIdx.x - 64) + (G - 64) * wave; tstep = (G - 64) * 8; tend = 576; }
    for (int task = task0; task < tend; task += tstep) {
        const int sc = task >> 1, tile = task & 1;
        const int nseg = sc < 32 ? 16 : 8, item0 = sc < 32 ? sc * 16 : 512 + (sc - 32) * 8;
        f32x16 XT[2];
        for (int jt = 0; jt < 2; ++jt) for (int i = 0; i < 16; ++i) XT[jt][i] = 0.f;
        bf16x8 pn[2][4]; f32x16 nq[2];
#define CH_LOAD(sg_) do { const bf16_t* Pm_ = PBh + (size_t)(item0 + (sg_)) * 4096; const float* Nm_ = NB + (size_t)(item0 + (sg_)) * 4096 + 4 * hh * 64 + 32 * tile + c; \
        _Pragma("unroll") for (int jt = 0; jt < 2; ++jt) { _Pragma("unroll") for (int s = 0; s < 4; ++s) { \
            const bf16_t* q = Pm_ + (32 * jt + c) * 64 + 16 * s + 4 * hh; const s16x4 lo = *(const s16x4*)q, hi = *(const s16x4*)(q + 8); \
            pn[jt][s] = __builtin_shufflevector(lo, hi, 0, 1, 2, 3, 4, 5, 6, 7); } \
            _Pragma("unroll") for (int i = 0; i < 16; ++i) nq[jt][i] = Nm_[(32 * jt + crow(i, 0)) * 64]; } } while (0)
        CH_LOAD(0);
#pragma unroll 1
        for (int sg = 0; sg < nseg - 1; ++sg) {
            float* Nm = NB + (size_t)(item0 + sg) * 4096 + 4 * hh * 64 + 32 * tile + c;
            f32x16 nn[2]; nn[0] = nq[0]; nn[1] = nq[1];
            bf16x8 pa[2][4], xb[4];
#pragma unroll
            for (int jt = 0; jt < 2; ++jt)
#pragma unroll
                for (int s = 0; s < 4; ++s) pa[jt][s] = pn[jt][s];
            if (sg + 1 < nseg - 1) CH_LOAD(sg + 1);
#pragma unroll
            for (int s = 0; s < 4; ++s) xb[s] = pack_step(XT[s >> 1], s & 1);
#pragma unroll
            for (int jt = 0; jt < 2; ++jt) {
                f32x16 nx; for (int i = 0; i < 16; ++i) nx[i] = 0.f;
#pragma unroll
                for (int s = 0; s < 4; ++s) nx = MFMA32(pa[jt][s], xb[s], nx);
#pragma unroll
                for (int i = 0; i < 16; ++i) { XT[jt][i] = nx[i] + nn[jt][i]; Nm[(32 * jt + crow(i, 0)) * 64] = XT[jt][i]; }
            }
        }
#undef CH_LOAD
    }
}

DI void ypost_phase(const Params& p) {
    const int TID = tid_();
    const bf16_t* P = (const bf16_t*)(p.ws + WS_P); const bf16_t* YD = (const bf16_t*)(p.ws + WS_YDIR); const float* COEF = (const float*)(p.ws + WS_COEF);
    const bf16_t* GUPT = (const bf16_t*)(p.ws + WS_GUPT); bf16_t* YA = (bf16_t*)(p.ws + WS_YA);
    bf16_t* SG = (bf16_t*)smem;
    float* GL = (float*)(smem + 16384);
    const int w = __builtin_amdgcn_readfirstlane(TID >> 6), lane = TID & 63, c = lane & 31, hh = lane >> 5;
    bf16x8 gf[2][8];
#pragma unroll
    for (int q = 0; q < 2; ++q)
#pragma unroll
        for (int s = 0; s < 8; ++s) gf[q][s] = *(const bf16x8*)(GUPT + (size_t)(w * 64 + 32 * q + c) * 128 + 16 * s + 8 * hh);
    const int et = TID >> 4, e16 = TID & 15;
    for (int item = blockIdx.x; item < MTOK / 32; item += gridDim.x) {
        const int m0 = item * 32; int base, T, sq; seq_of_token(m0, base, T, sq);
        { const int m = m0 + et, tok = m - base; float x[8];
          load_shift8(P, p.mu, m, 1792 + e16 * 8, tok > 0, tok < T - 1, x);
#pragma unroll
          for (int i = 0; i < 8; ++i) x[i] = sigmoidf_(x[i]);
          *(u32x4*)(SG + et * 136 + e16 * 8) = pack8(x); }
        __syncthreads();
#pragma unroll
        for (int q = 0; q < 2; ++q) { f32x16 g; for (int i = 0; i < 16; ++i) g[i] = 0.f;
#pragma unroll
            for (int s = 0; s < 8; ++s) g = MFMA32(lds_nat(SG, c, 136, s, hh), gf[q][s], g);
#pragma unroll
            for (int i = 0; i < 16; ++i) GL[crow(i, hh) * 516 + w * 64 + 32 * q + c] = g[i]; }
        __syncthreads();
        { const int m = m0 + et, tok = m - base; const bool hp = tok > 0, hn = tok < T - 1;
#pragma unroll
          for (int k = 0; k < 4; ++k) {
              const int fg = e16 + 16 * k, f0 = fg * 8, head = fg >> 3;
              float y0[8], y1[8], x[8];
              unpack8(*(const u32x4*)(YD + (size_t)m * 512 + f0), y0); unpack8(*(const u32x4*)(YD + ((size_t)MTOK + m) * 512 + f0), y1);
              load_shift8(P, p.mu, m, 1024 + f0, hp, hn, x);
              const float cf = COEF[(size_t)m * 8 + head] + COEF[((size_t)MTOK + m) * 8 + head];
              const f32x4 g0 = *(const f32x4*)(GL + et * 516 + f0), g1 = *(const f32x4*)(GL + et * 516 + f0 + 4);
              const f32x4 w0 = *(const f32x4*)(p.lnx_w + f0), w1 = *(const f32x4*)(p.lnx_w + f0 + 4), b0 = *(const f32x4*)(p.lnx_b + f0), b1 = *(const f32x4*)(p.lnx_b + f0 + 4);
              float sm = 0.f;
#pragma unroll
              for (int i = 0; i < 8; ++i) { y0[i] += y1[i]; sm += y0[i]; }
              sm = sum8_dpp(sm);
              const float mean = sm * (1.f / 64.f); float vs = 0.f;
#pragma unroll
              for (int i = 0; i < 8; ++i) { y0[i] -= mean; vs += y0[i] * y0[i]; }
              vs = sum8_dpp(vs);
              const float rstd = rsqrtf(vs * (1.f / 64.f) + 64e-5f);
              float o[8];
#pragma unroll
              for (int i = 0; i < 8; ++i) { const float lw_ = i < 4 ? w0[i & 3] : w1[i & 3], lb_ = i < 4 ? b0[i & 3] : b1[i & 3], gg = i < 4 ? g0[i & 3] : g1[i & 3];
                  o[i] = (y0[i] * rstd * lw_ + lb_ + cf * x[i]) * gg; }
              *(u32x4*)(YA + (size_t)m * 512 + f0) = pack8(o);
          } }
        __syncthreads();
    }
}

DI void prologue_phase(const Params& p) {
    const int TID = tid_();
    const int wave = TID >> 6, lane = TID & 63, gw = blockIdx.x * 8 + wave, ngw = gridDim.x * 8;
    float* scr = (float*)smem + wave * (64 * 33);
    unsigned char* ws = p.ws;
    { u32x4* z = (u32x4*)(ws + WS_WIN + 2688ull * 1024 * 2); const u32x4 zero = {0u, 0u, 0u, 0u};
      for (int i = blockIdx.x * 512 + TID; i < 128 * 1024 * 2 / 16; i += gridDim.x * 512) z[i] = zero; }
    constexpr int I_GU = (1024 / 64) * (2816 / 32), I_D = (2816 / 64) * (1024 / 32), I_IN = (1024 / 64) * (2688 / 32), I_G = (1024 / 64) * (2048 / 32),
                  I_BR = (512 / 64) * (1024 / 32), I_OUT = (1024 / 64) * (1024 / 32), I_LU = 1 * (512 / 32), I_GL = 2 * (512 / 32);
    constexpr int NITEMS = 4 * I_GU + 2 * I_D + I_IN + I_G + 2 * I_BR + I_OUT + 4 * I_LU + I_GL;
    for (int it = gw; it < NITEMS; it += ngw) {
        int r = it; TJob j; bool found = false;
#define TRY(cnt, W_, ldw_, K_, c0_, nc_, WT_, dr_, mode_) if (!found) { if (r < (cnt)) { j.W = (W_); j.ldw = (ldw_); j.K = (K_); j.ncol0 = (c0_); j.ncols = (nc_); j.WT = (bf16_t*)(WT_); j.dstrow0 = (dr_); j.mode = (mode_); found = true; } else r -= (cnt); }
        TRY(I_GU, p.ffn_wg, 2816, 1024, 0, 2816, ws + WS_WFFN1GU, 0, 1)
        TRY(I_GU, p.ffn_wu, 2816, 1024, 0, 2816, ws + WS_WFFN1GU, 0, 2)
        TRY(I_D, p.ffn_wd, 1024, 2816, 0, 1024, ws + WS_WFFN1D, 0, 0)
        TRY(I_GU, p.ffn_wg + 1024ull * 2816, 2816, 1024, 0, 2816, ws + WS_WFFN2GU, 0, 1)
        TRY(I_GU, p.ffn_wu + 1024ull * 2816, 2816, 1024, 0, 2816, ws + WS_WFFN2GU, 0, 2)
        TRY(I_D, p.ffn_wd + 2816ull * 1024, 1024, 2816, 0, 1024, ws + WS_WFFN2D, 0, 0)
        TRY(I_IN, p.w_in, 4736, 1024, 0, 2688, ws + WS_WIN, 0, 0)
        TRY(I_G, p.w_in, 4736, 1024, 2688, 2048, ws + WS_WG, 0, 0)
        TRY(I_BR, p.w_ba, 1024, 512, 0, 1024, ws + WS_WA, 0, 0)
        TRY(I_BR, p.w_bb, 1024, 512, 0, 1024, ws + WS_WB, 0, 0)
        TRY(I_OUT, p.w_out, 1024, 1024, 0, 1024, ws + WS_WOUT, 0, 0)
        TRY(I_LU, p.w_up, 512, 64, 0, 512, ws + WS_WUPT, 0, 0)
        TRY(I_LU, p.w_up + 64 * 512, 512, 64, 0, 512, ws + WS_WUPT, 512, 0)
        TRY(I_LU, p.a_up, 512, 64, 0, 512, ws + WS_AUPT, 0, 0)
        TRY(I_LU, p.a_up + 64 * 512, 512, 64, 0, 512, ws + WS_AUPT, 512, 0)
        TRY(I_GL, p.g_up, 512, 128, 0, 512, ws + WS_GUPT, 0, 0)
#undef TRY
        if (found) tjob_run(j, r, scr, lane);
    }
    row_phase(p, 0, nullptr, 0.f, nullptr, p.norm_g, (bf16_t*)(ws + WS_H), gw, ngw, lane);
}

DI void row_job(const Params& p, int rowm) {
    const int TID = tid_();
    unsigned char* ws = p.ws;
    const int wave = TID >> 6, lane = TID & 63, gw = blockIdx.x * 8 + wave, ngw = gridDim.x * 8;
    const int mode = rowm == 0 ? 1 : (rowm == 1 ? 3 : 2);
    const bf16_t* f = rowm == 0 ? (const bf16_t*)(ws + WS_F1) : (rowm == 2 ? (const bf16_t*)(ws + WS_O) : (const bf16_t*)(ws + WS_F2));
    const float scale = rowm == 2 ? 1.0f : 0.5f;
    const float* gpost = p.norm_g + (rowm == 0 ? 1 : (rowm == 2 ? 3 : 5)) * DM;
    const float* gpre = p.norm_g + (rowm == 2 ? 4 : 2) * DM;
    bf16_t* hb = rowm == 0 ? (bf16_t*)(ws + WS_H) : (rowm == 1 ? (bf16_t*)(ws + WS_H2B) : (rowm == 2 ? (bf16_t*)(ws + WS_H3) : nullptr));
    row_phase(p, mode, f, scale, gpost, gpre, hb, gw, ngw, lane);
}

#define XB_TMO      128
#define XB_XCNT(j)  (256  + 64 * (j))
#define XB_XSUB(j)  (1280 + 64 * (j))
#define XB_XGEN(j)  (2304 + 64 * (j))
#define XB_TOP      3328
#define XB_TOPGEN   3392
#define XCD_BAR_WORDS 3456
#define XB_SPIN_CAP (1u << 18)
#define LAS __attribute__((address_space(3)))
DI unsigned xb_ld(unsigned* p)              { return __hip_atomic_load(p, __ATOMIC_RELAXED, __HIP_MEMORY_SCOPE_AGENT); }
DI unsigned xb_add(unsigned* p, unsigned v) { return __hip_atomic_fetch_add(p, v, __ATOMIC_RELAXED, __HIP_MEMORY_SCOPE_AGENT); }
DI unsigned xb_xcc_id() { return (unsigned)__builtin_amdgcn_s_getreg((3 << 11) | 20) & 0xFu; }
#define XB_SPIN(cond, bar) do { unsigned _sp = 0; while (cond) { __builtin_amdgcn_s_sleep(1); \
    if ((++_sp & 255u) == 0u) { if (xb_ld(&(bar)[XB_TMO])) break; if (_sp > XB_SPIN_CAP) { atomicAdd(&(bar)[XB_TMO], 1u); break; } } } } while (0)
struct XcdBarrier { unsigned* bar; unsigned x; volatile LAS unsigned* st; };
DI XcdBarrier xcd_barrier_post(unsigned* bar, volatile LAS unsigned* st) {
    XcdBarrier b; b.bar = bar; b.x = xb_xcc_id(); b.st = st;
    if (threadIdx.x == 0) (void)xb_add(&bar[XB_XCNT(b.x)], 1u);
    return b;
}
DI void xcd_barrier_complete(unsigned* bar, unsigned x, unsigned& nloc, unsigned& nx) {
    const unsigned G = gridDim.x * gridDim.y * gridDim.z;
    unsigned sum, cnt, mine, sp = 0u;
    for (;;) {
        sum = 0u; cnt = 0u; mine = 0u;
#pragma unroll
        for (unsigned j = 0; j < 16; ++j) { const unsigned c = xb_ld(&bar[XB_XCNT(j)]); sum += c; cnt += (c > 0u) ? 1u : 0u; mine = (j == x) ? c : mine; }
        if (sum == G) break;
        __builtin_amdgcn_s_sleep(1);
        if ((++sp & 255u) == 0u) { if (xb_ld(&bar[XB_TMO])) break; if (sp > XB_SPIN_CAP) { atomicAdd(&bar[XB_TMO], 1u); break; } }
    }
    nloc = mine > 0u ? mine : 1u; nx = cnt > 0u ? cnt : 1u;
}
DI void xcd_barrier(const XcdBarrier& b) {
    asm volatile("s_waitcnt vmcnt(0)" ::: "memory");
    __syncthreads();
    if (threadIdx.x == 0) {
        unsigned* bar = b.bar;
        __builtin_amdgcn_s_waitcnt(0);
        unsigned nloc = b.st[0], nx = b.st[1];
        if (nloc == 0u) { xcd_barrier_complete(bar, b.x, nloc, nx); b.st[0] = nloc; b.st[1] = nx; }
        const unsigned old = xb_add(&bar[XB_XSUB(b.x)], 1u);
        const unsigned gen = old / nloc;
        if (old + 1u == (gen + 1u) * nloc) {
            __builtin_amdgcn_fence(__ATOMIC_RELEASE, "agent");
            asm volatile("s_waitcnt vmcnt(0)" ::: "memory");
            const unsigned og = xb_add(&bar[XB_TOP], 1u);
            const unsigned tg = og / nx;
            if (og + 1u == (tg + 1u) * nx) xb_add(&bar[XB_TOPGEN], 1u);
            else XB_SPIN(xb_ld(&bar[XB_TOPGEN]) == tg, bar);
            __builtin_amdgcn_fence(__ATOMIC_ACQUIRE, "agent");
            xb_add(&bar[XB_XGEN(b.x)], 1u);
            asm volatile("s_waitcnt vmcnt(0)" ::: "memory");
        } else {
            XB_SPIN(xb_ld(&bar[XB_XGEN(b.x)]) == gen, bar);
            __builtin_amdgcn_fence(__ATOMIC_ACQUIRE, "agent");
            asm volatile("s_waitcnt vmcnt(0)" ::: "memory");
        }
    }
    __syncthreads();
}

__global__ void __launch_bounds__(512) fwd_megakernel(Params p) {
    cg::grid_group grid = cg::this_grid();
    unsigned* bar = (unsigned*)(p.ws + WS_BAR);
    volatile LAS unsigned* st = (volatile LAS unsigned*)(LAS unsigned char*)(smem + LDS_MAIN);
    if (threadIdx.x < 4) st[threadIdx.x] = 0u;
    if (blockIdx.x == 0) for (int i = threadIdx.x; i < XCD_BAR_WORDS; i += 512) bar[i] = 0u;
    prologue_phase(p);      grid.sync();
    const XcdBarrier xb = xcd_barrier_post(bar, st);
    gemm_job(p, 0);         xcd_barrier(xb);
    gemm_job(p, 1);         xcd_barrier(xb);
    row_job(p, 0);          xcd_barrier(xb);
    gemm_job(p, 2);         xcd_barrier(xb);
    attn_prep_phase(p); __syncthreads();
    rwkv_pass(p, 0);        xcd_barrier(xb);
    rwkv_chain(p); __syncthreads();
    attn_phase(p);          xcd_barrier(xb);
    rwkv_pass(p, 1);        xcd_barrier(xb);
    ypost_phase(p);         xcd_barrier(xb);
    row_job(p, 1);          xcd_barrier(xb);
    gemm_job(p, 3);         xcd_barrier(xb);
    gemm_job(p, 4);         xcd_barrier(xb);
    row_job(p, 2);          xcd_barrier(xb);
    gemm_job(p, 5);         xcd_barrier(xb);
    gemm_job(p, 6);         xcd_barrier(xb);
    row_job(p, 3);
}

extern "C" void kernel_launch(void* const* d_in, const int* in_sizes, int n_in, void* d_out, int out_size, void* d_ws, size_t ws_size, hipStream_t stream) {
    static int grid_blocks = 0;
    if (grid_blocks == 0) {
        if (n_in != 23 || out_size != MTOK * DM || ws_size < WS_NEED) { fprintf(stderr, "kernel_launch: unexpected sizes n_in %d out %d ws %zu\n", n_in, out_size, ws_size); grid_blocks = -1; return; }
        int dev = 0, cus = 0, per_cu = 0;
        hipGetDevice(&dev); hipDeviceGetAttribute(&cus, hipDeviceAttributeMultiprocessorCount, dev);
        if (hipFuncSetAttribute((const void*)fwd_megakernel, hipFuncAttributeMaxDynamicSharedMemorySize, LDS_BYTES) != hipSuccess) { fprintf(stderr, "hipFuncSetAttribute failed\n"); }
        if (hipOccupancyMaxActiveBlocksPerMultiprocessor(&per_cu, (const void*)fwd_megakernel, 512, LDS_BYTES) != hipSuccess || per_cu < 1) { fprintf(stderr, "occupancy query: %d\n", per_cu); per_cu = 1; }
        (void)hipGetLastError();
        grid_blocks = cus * 1;
        if (grid_blocks > 256) grid_blocks = 256;
    }
    if (grid_blocks < 0) return;
    Params p{};
    const float* const* in = (const float* const*)d_in;
    p.xp = in[0]; p.xs = in[1]; p.norm_g = in[2]; p.ffn_wg = in[3]; p.ffn_wu = in[4]; p.ffn_wd = in[5]; p.w_in = in[6]; p.mu = in[7]; p.w0 = in[8]; p.w_up = in[9];
    p.a0 = in[10]; p.a_up = in[11]; p.g_up = in[12]; p.k_k = in[13]; p.k_a = in[14]; p.r_k = in[15]; p.lnx_w = in[16]; p.lnx_b = in[17]; p.qk_g = in[18];
    p.w_ba = in[19]; p.w_bb = in[20]; p.b_gate = in[21]; p.w_out = in[22];
    p.out = (float*)d_out; p.ws = (unsigned char*)d_ws;
    void* args[] = {&p};
    hipError_t e = hipLaunchCooperativeKernel((void*)fwd_megakernel, dim3(grid_blocks), dim3(512), args, LDS_BYTES, stream);
    if (e != hipSuccess) fprintf(stderr, "cooperative launch failed: %s (grid %d)\n", hipGetErrorString(e), grid_blocks);
}
```

```cpp
#include <hip/hip_runtime.h>
#include <hip/hip_cooperative_groups.h>
#include <cstdio>
#include <cstdint>
namespace cg = cooperative_groups;

typedef unsigned short bf16_t;
typedef short bf16x8 __attribute__((ext_vector_type(8)));
typedef short s16x4 __attribute__((ext_vector_type(4)));
typedef float f32x2 __attribute__((ext_vector_type(2)));
typedef float f32x4 __attribute__((ext_vector_type(4)));
typedef float f32x16 __attribute__((ext_vector_type(16)));
typedef unsigned u32x2 __attribute__((ext_vector_type(2)));
typedef unsigned u32x4 __attribute__((ext_vector_type(4)));
typedef __bf16 bf16x2n __attribute__((ext_vector_type(2)));
#define DI __device__ __forceinline__

constexpr int MTOK = 49152, MPROMPT = 16384, DM = 1024, DFF = 2816, NPC = 2688  , NPCPAD = 2816;
constexpr int TP = 8192, TS = 2048;
constexpr size_t MiB = 1024ull * 1024ull;
constexpr size_t WS_WFFN1GU = 0;
constexpr size_t WS_WFFN1D  = WS_WFFN1GU + 5632ull * 1024 * 2;
constexpr size_t WS_WFFN2GU = WS_WFFN1D + 1024ull * 2816 * 2;
constexpr size_t WS_WFFN2D  = WS_WFFN2GU + 5632ull * 1024 * 2;
constexpr size_t WS_WIN     = WS_WFFN2D + 1024ull * 2816 * 2;
constexpr size_t WS_WG      = WS_WIN + 2816ull * 1024 * 2;
constexpr size_t WS_WA      = WS_WG + 2048ull * 1024 * 2;
constexpr size_t WS_WB      = WS_WA + 1024ull * 512 * 2;
constexpr size_t WS_WOUT    = WS_WB + 1024ull * 512 * 2;
constexpr size_t WS_WUPT    = WS_WOUT + 1024ull * 1024 * 2;
constexpr size_t WS_AUPT    = WS_WUPT + 2ull * 512 * 64 * 2;
constexpr size_t WS_GUPT    = WS_AUPT + 2ull * 512 * 64 * 2;
constexpr size_t WS_R0END   = WS_GUPT + 512ull * 128 * 2;
constexpr size_t WS_BAR     = 47 * MiB;
static_assert(WS_R0END <= WS_BAR, "barrier words");
static_assert(WS_R0END <= 48 * MiB, "weights region");
constexpr size_t R1 = 48 * MiB;
constexpr size_t R2 = 312 * MiB;
constexpr size_t R3 = 408 * MiB;
constexpr size_t WS_HFF1 = R1, WS_P = R1, WS_H = R2, WS_F1 = R3;
constexpr size_t WS_NBUF = R2, WS_PBUF = R2 + 48 * MiB;
constexpr size_t WS_YDIR = R2 + 48 * MiB;
constexpr size_t WS_COEF = 456 * MiB;
constexpr size_t WS_KB   = 440 * MiB;
constexpr size_t WS_VT   = 452 * MiB;
constexpr size_t WS_QB   = 464 * MiB;
constexpr size_t WS_YA   = R2;
constexpr size_t WS_H2B  = R1;
constexpr size_t WS_MERGED = R1 + 96 * MiB;
constexpr size_t WS_SCR  = R1 + 192 * MiB;
constexpr size_t WS_O    = 368 * MiB;
constexpr size_t WS_H3   = R1;
constexpr size_t WS_HFF2 = R1 + 96 * MiB;
constexpr size_t WS_F2   = R3;
constexpr size_t WS_NEED = 512 * MiB;

struct Params {
    const float* xp; const float* xs; const float* norm_g; const float* ffn_wg; const float* ffn_wu; const float* ffn_wd;
    const float* w_in; const float* mu; const float* w0; const float* w_up; const float* a0; const float* a_up; const float* g_up;
    const float* k_k; const float* k_a; const float* r_k; const float* lnx_w; const float* lnx_b; const float* qk_g;
    const float* w_ba; const float* w_bb; const float* b_gate; const float* w_out;
    float* out; unsigned char* ws;
};

DI unsigned pk2(float lo, float hi) { f32x2 v = {lo, hi}; bf16x2n b = __builtin_convertvector(v, bf16x2n); return __builtin_bit_cast(unsigned, b); }
DI bf16_t f2bf(float x) { return (bf16_t)(pk2(x, 0.f) & 0xffffu); }
DI float bf2f(bf16_t b) { return __uint_as_float(((unsigned)b) << 16); }
DI float bflo(unsigned u) { return __uint_as_float(u << 16); }
DI float bfhi(unsigned u) { return __uint_as_float(u & 0xffff0000u); }
DI void unpack8(u32x4 u, float* f) { f[0] = bflo(u.x); f[1] = bfhi(u.x); f[2] = bflo(u.y); f[3] = bfhi(u.y); f[4] = bflo(u.z); f[5] = bfhi(u.z); f[6] = bflo(u.w); f[7] = bfhi(u.w); }
DI u32x4 pack8(const float* f) { u32x4 u; u.x = pk2(f[0], f[1]); u.y = pk2(f[2], f[3]); u.z = pk2(f[4], f[5]); u.w = pk2(f[6], f[7]); return u; }
DI int crow(int reg, int h) { return (reg & 3) + 8 * (reg >> 2) + 4 * h; }
#define MFMA32(a, b, c) __builtin_amdgcn_mfma_f32_32x32x16_bf16((a), (b), (c), 0, 0, 0)
DI bf16x8 pack_step(const f32x16& x, int s) {
    u32x4 p; p.x = pk2(x[8 * s], x[8 * s + 1]); p.y = pk2(x[8 * s + 2], x[8 * s + 3]); p.z = pk2(x[8 * s + 4], x[8 * s + 5]); p.w = pk2(x[8 * s + 6], x[8 * s + 7]);
    return __builtin_bit_cast(bf16x8, p);
}
DI const float* xrow(const Params& p, int m) { return m < MPROMPT ? p.xp + (size_t)m * DM : p.xs + (size_t)(m - MPROMPT) * DM; }
DI float wave_sum(float v) {
#pragma unroll
    for (int o = 1; o < 64; o <<= 1) v += __shfl_xor(v, o);
    return v;
}
DI float sigmoidf_(float x) { return __builtin_amdgcn_rcpf(1.f + __expf(-x)); }
DI float tanhf_(float x) { return 1.f - 2.f * __builtin_amdgcn_rcpf(1.f + __builtin_amdgcn_exp2f(x * 2.8853900817779268f)); }
DI float sum8_dpp(float v) {
    v += __int_as_float(__builtin_amdgcn_mov_dpp(__float_as_int(v), 0xB1, 0xF, 0xF, false));
    v += __int_as_float(__builtin_amdgcn_mov_dpp(__float_as_int(v), 0x4E, 0xF, 0xF, false));
    v += __int_as_float(__builtin_amdgcn_mov_dpp(__float_as_int(v), 0x141, 0xF, 0xF, false));
    return v;
}
DI int tid_() { int t = threadIdx.x; asm volatile("" : "+v"(t)); return t; }

extern __shared__ __attribute__((aligned(16))) unsigned char smem[];
constexpr int LDS_MAIN = 161280;
constexpr int LDS_BYTES = LDS_MAIN + 16;

DI void transpose_item(const float* W, int ldw, int K, int k0, int nsrc, bf16_t* WT, int dstrow, float* scr, int lane) {
#pragma unroll
    for (int i = 0; i < 8; ++i) { const int kk = 8 * i + (lane >> 3), n4 = (lane & 7) * 4; const f32x4 v = *(const f32x4*)(W + (size_t)(k0 + kk) * ldw + nsrc + n4);
        float* d = scr + kk * 33 + n4; d[0] = v[0]; d[1] = v[1]; d[2] = v[2]; d[3] = v[3]; }
    __builtin_amdgcn_fence(__ATOMIC_RELEASE, "wavefront"); __builtin_amdgcn_wave_barrier(); __builtin_amdgcn_fence(__ATOMIC_ACQUIRE, "wavefront");
    const int c = lane & 7;
#pragma unroll
    for (int j = 0; j < 4; ++j) { const int n = (lane >> 3) + 8 * j; const float* s = scr + (8 * c) * 33 + n;
        u32x4 o; o.x = pk2(s[0 * 33], s[1 * 33]); o.y = pk2(s[2 * 33], s[3 * 33]); o.z = pk2(s[4 * 33], s[5 * 33]); o.w = pk2(s[6 * 33], s[7 * 33]);
        *(u32x4*)(WT + (size_t)(dstrow + n) * K + k0 + 8 * c) = o; }
    __builtin_amdgcn_fence(__ATOMIC_RELEASE, "wavefront"); __builtin_amdgcn_wave_barrier(); __builtin_amdgcn_fence(__ATOMIC_ACQUIRE, "wavefront");
}
struct TJob { const float* W; int ldw, K, ncol0, ncols; bf16_t* WT; int dstrow0; int mode; };
DI int tjob_items(const TJob& j) { return (j.K / 64) * (j.ncols / 32); }
DI void tjob_run(const TJob& j, int item, float* scr, int lane) {
    const int nblk = j.ncols / 32, kb = item / nblk, nb = item % nblk, n0 = 32 * nb;
    int drow = j.dstrow0 + n0;
    if (j.mode) drow = 256 * (n0 >> 7) + (j.mode == 2 ? 128 : 0) + (n0 & 127);
    transpose_item(j.W, j.ldw, j.K, 64 * kb, j.ncol0 + n0, j.WT, drow, scr, lane);
}

DI void row_phase(const Params& p, int mode, const bf16_t* fbuf, float scale, const float* gpost, const float* gpre, bf16_t* hbuf, int gw, int ngw, int lane) {
    for (int m = gw; m < MTOK; m += ngw) {
        const float* xr = (mode <= 1) ? xrow(p, m) : p.out + (size_t)m * DM;
        f32x4 v[4];
#pragma unroll
        for (int j = 0; j < 4; ++j) v[j] = *(const f32x4*)(xr + 4 * lane + 256 * j);
        if (mode == 1 || mode == 2) {
            const bf16_t* fr = fbuf + (size_t)m * DM;
            f32x4 f[4]; float ss = 0.f;
#pragma unroll
            for (int j = 0; j < 4; ++j) { u32x2 u = *(const u32x2*)(fr + 4 * lane + 256 * j); f[j] = (f32x4){bflo(u.x), bfhi(u.x), bflo(u.y), bfhi(u.y)};
                ss += f[j].x * f[j].x + f[j].y * f[j].y + f[j].z * f[j].z + f[j].w * f[j].w; }
            const float rs = rsqrtf(wave_sum(ss) * (1.f / DM) + 1e-6f) * scale;
#pragma unroll
            for (int j = 0; j < 4; ++j) { const f32x4 g = *(const f32x4*)(gpost + 4 * lane + 256 * j); v[j] = v[j] + f[j] * g * rs; }
            float* xo = p.out + (size_t)m * DM;
#pragma unroll
            for (int j = 0; j < 4; ++j) *(f32x4*)(xo + 4 * lane + 256 * j) = v[j];
        }
        if (hbuf) {
            float ss = 0.f;
#pragma unroll
            for (int j = 0; j < 4; ++j) ss += v[j].x * v[j].x + v[j].y * v[j].y + v[j].z * v[j].z + v[j].w * v[j].w;
            const float rs = rsqrtf(wave_sum(ss) * (1.f / DM) + 1e-6f);
            bf16_t* hr = hbuf + (size_t)m * DM;
#pragma unroll
            for (int j = 0; j < 4; ++j) { const f32x4 g = *(const f32x4*)(gpre + 4 * lane + 256 * j); const f32x4 y = v[j] * g * rs;
                u32x2 o; o.x = pk2(y.x, y.y); o.y = pk2(y.z, y.w); *(u32x2*)(hr + 4 * lane + 256 * j) = o; }
        }
    }
}

constexpr int BM = 256, BK = 64, HALF = 128, NXCD = 8, WGM = 8, HT = HALF * BK;
DI int lds_byte(int r, int c) { int st = (r >> 4) * 2 + (c >> 5), rr = r & 15, cc = c & 31, ob = rr * 64 + cc * 2; return st * 1024 + (ob ^ (((ob >> 9) & 1) << 5)); }
DI void stage_rc(int b, int& R, int& C) { int st = b / 1024, sb = b % 1024, swz = sb ^ (((sb >> 9) & 1) << 5); R = (st >> 1) * 16 + swz / 64; C = (st & 1) * 32 + (swz % 64) / 2; }
DI bool tile_order(int nM, int nN, int i, int G, int c, int& pm, int& pn) {
    const int nwg = nM * nN; const long L = (long)i * G + c; if (L >= nwg) return false;
    int wgid = (int)L; { const int q = nwg / NXCD, r = nwg % NXCD, xcd = wgid % NXCD, off = wgid / NXCD; wgid = (xcd < r ? xcd * (q + 1) : r * (q + 1) + (xcd - r) * q) + off; }
    const int nig = WGM * nN, gid = wgid / nig, fm = gid * WGM, gsz = (nM - fm) < WGM ? (nM - fm) : WGM;
    pm = fm + ((wgid % nig) % gsz); pn = (wgid % nig) / gsz; return true;
}
#define ACC_T f32x4 (&acc)[2][2][4][2]
template <class Epi>
DI void gemm_tile(const bf16_t* __restrict__ A, const bf16_t* __restrict__ Bt, int K, int brow, int bcol, const Epi& epi,
               bool pre  , bool hasNext, const bf16_t* An, const bf16_t* Btn, int Kn, int brown, int bcoln) {
    bf16_t* shm = (bf16_t*)smem;
#define SA(b, h) (shm + ((b) * 2 + (h)) * HT)
#define SB(b, h) (shm + (4 + (b) * 2 + (h)) * HT)
#define STAGEX(P, BASE, br, kt, K_, voff_) do { const char* _gb = (const char*)(BASE) + ((long)(br) * (K_) + (long)(kt) * BK) * 2; \
    _Pragma("unroll") for (int _i = 0; _i < 2; ++_i) \
      __builtin_amdgcn_global_load_lds((const unsigned*)(_gb + voff_[_i]), (unsigned*)((char*)(P) + wid * 1024 + _i * 8192), 16, 0, 0); } while (0)
#define STAGE(P, BASE, br, kt) STAGEX(P, BASE, br, kt, K, voff)
#define LDA(dst, b, h) for (int m = 0; m < 4; ++m) for (int k = 0; k < 2; ++k) \
    dst[m][k] = *reinterpret_cast<const bf16x8*>((char*)SA(b, h) + lds_byte(wr * 64 + m * 16 + fr, k * 32 + fq * 8))
#define LDB(dst, b, h) for (int n = 0; n < 2; ++n) for (int k = 0; k < 2; ++k) \
    dst[n][k] = *reinterpret_cast<const bf16x8*>((char*)SB(b, h) + lds_byte(wc * 32 + n * 16 + fr, k * 32 + fq * 8))
#define MMA(ai, bj, At_, Bt_) do { __builtin_amdgcn_s_setprio(1); \
    for (int m = 0; m < 4; ++m) for (int n = 0; n < 2; ++n) for (int k = 0; k < 2; ++k) \
      acc[ai][bj][m][n] = __builtin_amdgcn_mfma_f32_16x16x32_bf16(Bt_[n][k], At_[m][k], acc[ai][bj][m][n], 0, 0, 0); \
    __builtin_amdgcn_s_setprio(0); } while (0)
#define WAIT_V(n) asm volatile("s_waitcnt vmcnt(" #n ")" ::: "memory")
#define WAIT_L(n) asm volatile("s_waitcnt lgkmcnt(" #n ")" ::: "memory")
#define BAR __builtin_amdgcn_s_barrier()
#define SCHED __builtin_amdgcn_sched_barrier(0)
    const int tid = tid_(), wid = __builtin_amdgcn_readfirstlane(tid >> 6), lane = tid & 63, wr = wid >> 2, wc = wid & 3, fr = lane & 15, fq = lane >> 4;
    unsigned voff[2];
#pragma unroll
    for (int i = 0; i < 2; ++i) { int R, C; stage_rc(tid * 16 + i * 8192, R, C); voff[i] = (unsigned)(R * K + C) * 2u; }
    f32x4 acc[2][2][4][2] = {};
    bf16x8 At[4][2], B0[2][2], B1[2][2];
    const int nt = K / BK;
    if (!pre) { STAGE(SB(0, 0), Bt, bcol, 0); STAGE(SA(0, 0), A, brow, 0);
                STAGE(SB(0, 1), Bt, bcol + HALF, 0); STAGE(SA(0, 1), A, brow + HALF, 0); }
    if (wr == 1) BAR;
    if (pre) WAIT_V(0); else WAIT_V(4);
    BAR;
    STAGE(SB(1, 0), Bt, bcol, 1); STAGE(SA(1, 0), A, brow, 1); STAGE(SB(1, 1), Bt, bcol + HALF, 1);
    WAIT_V(6); BAR;
#pragma unroll 1
    for (int t = 0; t < nt - 2; t += 2) {
        LDB(B0, 0, 0); SCHED; LDA(At, 0, 0); STAGE(SA(1, 1), A, brow + HALF, t + 1);
        WAIT_L(8); BAR; WAIT_L(0); MMA(0, 0, At, B0); BAR; SCHED;
        LDB(B1, 0, 1); STAGE(SB(0, 0), Bt, bcol, t + 2);
        BAR; WAIT_L(0); MMA(0, 1, At, B1); BAR;
        LDA(At, 0, 1); STAGE(SA(0, 0), A, brow, t + 2);
        BAR; WAIT_L(0); MMA(1, 0, At, B0); BAR; SCHED;
        STAGE(SB(0, 1), Bt, bcol + HALF, t + 2);
        WAIT_V(6); BAR; MMA(1, 1, At, B1); BAR;
        LDB(B0, 1, 0); SCHED; LDA(At, 1, 0); STAGE(SA(0, 1), A, brow + HALF, t + 2);
        WAIT_L(8); BAR; WAIT_L(0); MMA(0, 0, At, B0); BAR; SCHED;
        LDB(B1, 1, 1); STAGE(SB(1, 0), Bt, bcol, t + 3);
        BAR; WAIT_L(0); MMA(0, 1, At, B1); BAR;
        LDA(At, 1, 1); STAGE(SA(1, 0), A, brow, t + 3);
        BAR; WAIT_L(0); MMA(1, 0, At, B0); BAR; SCHED;
        STAGE(SB(1, 1), Bt, bcol + HALF, t + 3);
        WAIT_V(6); BAR; MMA(1, 1, At, B1); BAR;
    }
    { LDB(B0, 0, 0); LDA(At, 0, 0); STAGE(SA(1, 1), A, brow + HALF, nt - 1);
      BAR; WAIT_L(0); MMA(0, 0, At, B0); BAR;
      LDB(B1, 0, 1); BAR; WAIT_L(0); MMA(0, 1, At, B1); BAR;
      LDA(At, 0, 1); WAIT_V(4); BAR; WAIT_L(0); MMA(1, 0, At, B0); MMA(1, 1, At, B1); BAR; }
    { LDB(B0, 1, 0); LDA(At, 1, 0); WAIT_V(2); BAR; WAIT_L(0); MMA(0, 0, At, B0); BAR;
      LDB(B1, 1, 1); WAIT_V(0); BAR; WAIT_L(0); MMA(0, 1, At, B1); BAR;
      LDA(At, 1, 1); BAR; WAIT_L(0); MMA(1, 0, At, B0); MMA(1, 1, At, B1); BAR; }
    if (wr == 0) BAR;
    if (hasNext) {
        unsigned voffn[2];
#pragma unroll
        for (int i = 0; i < 2; ++i) { int R, C; stage_rc(tid * 16 + i * 8192, R, C); voffn[i] = (unsigned)(R * Kn + C) * 2u; }
        STAGEX(SB(0, 0), Btn, bcoln, 0, Kn, voffn); STAGEX(SA(0, 0), An, brown, 0, Kn, voffn);
        STAGEX(SB(0, 1), Btn, bcoln + HALF, 0, Kn, voffn); STAGEX(SA(0, 1), An, brown + HALF, 0, Kn, voffn);
    }
    SCHED;
    epi(acc, brow, bcol, wr, wc, fr, fq);
#undef SA
#undef SB
}

struct EpiAny {
    int kind; bf16_t* O; int ldc; int ncols;
    bf16_t* T; int ldt; int trow0, tcol0; const float* bias; const bf16_t* S1;
    DI void operator()(ACC_T, int brow, int bcol, int wr, int wc, int fr, int fq) const {
        if (kind <= 1) {
            unsigned char* L = smem;
            if (kind == 0) {
#pragma unroll
                for (int ai = 0; ai < 2; ++ai)
#pragma unroll
                    for (int m = 0; m < 4; ++m) { const int row = ai * HALF + wr * 64 + m * 16 + fr;
#pragma unroll
                        for (int bj = 0; bj < 2; ++bj)
#pragma unroll
                            for (int n = 0; n < 2; ++n) { const f32x4 v = acc[ai][bj][m][n]; const int slot = (bj * 32 + wc * 8 + n * 4 + fq + 4 * fr) & 63;
                                u32x2 o; o.x = pk2(v[0], v[1]); o.y = pk2(v[2], v[3]); *(u32x2*)(L + row * 512 + slot * 8) = o; } }
            } else {
#pragma unroll
                for (int ai = 0; ai < 2; ++ai)
#pragma unroll
                    for (int m = 0; m < 4; ++m) { const int row = ai * HALF + wr * 64 + m * 16 + fr;
#pragma unroll
                        for (int n = 0; n < 2; ++n) { const f32x4 g = acc[ai][0][m][n], u = acc[ai][1][m][n]; float r[4];
#pragma unroll
                            for (int j = 0; j < 4; ++j) r[j] = g[j] * __builtin_amdgcn_rcpf(1.f + __expf(-g[j])) * u[j];
                            const int slot = (wc * 8 + n * 4 + fq + 4 * fr) & 31;
                            u32x2 o; o.x = pk2(r[0], r[1]); o.y = pk2(r[2], r[3]); *(u32x2*)(L + row * 256 + slot * 8) = o; } }
            }
            asm volatile("s_waitcnt lgkmcnt(0)" ::: "memory"); __builtin_amdgcn_s_barrier(); asm volatile("" ::: "memory");
            const int tid = (wr * 4 + wc) * 64 + fq * 16 + fr;
            if (kind == 0) {
#pragma unroll
                for (int k = 0; k < 16; ++k) { const int pp = tid + 512 * k, row = pp >> 5, pc = pp & 31, slot = (2 * pc + 4 * (row & 15)) & 63;
                    const u32x4 v = *(const u32x4*)(L + row * 512 + slot * 8); const int col = bcol + pc * 8;
                    if (col < ncols) *(u32x4*)(O + (size_t)(brow + row) * ldc + col) = v; }
            } else {
#pragma unroll
                for (int k = 0; k < 8; ++k) { const int pp = tid + 512 * k, row = pp >> 4, pc = pp & 15, slot = (2 * pc + 4 * (row & 15)) & 31;
                    const u32x4 v = *(const u32x4*)(L + row * 256 + slot * 8);
                    *(u32x4*)(O + (size_t)(brow + row) * DFF + (bcol >> 1) + pc * 8) = v; }
            }
            asm volatile("s_waitcnt lgkmcnt(0)" ::: "memory"); __builtin_amdgcn_s_barrier(); asm volatile("" ::: "memory");
            return;
        }
        unsigned char* L = smem;
        const int tid = (wr * 4 + wc) * 64 + fq * 16 + fr;
#define EPI_BAR do { asm volatile("s_waitcnt lgkmcnt(0)" ::: "memory"); __builtin_amdgcn_s_barrier(); asm volatile("" ::: "memory"); } while (0)
#define EPI_WIDE_LOAD(PTR_, LD_, R0_, C0_) do { _Pragma("unroll 1") for (int k4 = 0; k4 < 16; k4 += 2) _Pragma("unroll") for (int k = k4; k < k4 + 2; ++k) { const int pp = tid + 512 * k, row = pp >> 5, pc = pp & 31, slot = (2 * pc + 4 * (row & 15)) & 63; \
            *(u32x4*)(L + row * 512 + slot * 8) = *(const u32x4*)((PTR_) + (size_t)(brow + row - (R0_)) * (LD_) + (bcol + pc * 8 - (C0_))); } } while (0)
#define EPI_WIDE_STORE(PTR_, LD_, R0_, C0_) do { _Pragma("unroll 1") for (int k4 = 0; k4 < 16; k4 += 2) _Pragma("unroll") for (int k = k4; k < k4 + 2; ++k) { const int pp = tid + 512 * k, row = pp >> 5, pc = pp & 31, slot = (2 * pc + 4 * (row & 15)) & 63; \
            *(u32x4*)((PTR_) + (size_t)(brow + row - (R0_)) * (LD_) + (bcol + pc * 8 - (C0_))) = *(const u32x4*)(L + row * 512 + slot * 8); } } while (0)
#define EPI_SLOT(ai_, m_, bj_, n_) (L + (ai_ * HALF + wr * 64 + m_ * 16 + fr) * 512 + ((bj_ * 32 + wc * 8 + n_ * 4 + fq + 4 * fr) & 63) * 8)
        if (kind == 2) {
            const int col0 = bcol + wc * 32 + fq * 4;
            f32x4 bv[2][2];
#pragma unroll
            for (int bj = 0; bj < 2; ++bj)
#pragma unroll
                for (int n = 0; n < 2; ++n) bv[bj][n] = *(const f32x4*)(bias + col0 + bj * HALF + n * 16);
#pragma unroll
            for (int ai = 0; ai < 2; ++ai)
#pragma unroll
                for (int m = 0; m < 4; ++m)
#pragma unroll
                    for (int bj = 0; bj < 2; ++bj)
#pragma unroll
                        for (int n = 0; n < 2; ++n) { const f32x4 v = acc[ai][bj][m][n]; float r[4];
#pragma unroll
                            for (int j = 0; j < 4; ++j) r[j] = sigmoidf_(v[j] + bv[bj][n][j]);
                            u32x2 o; o.x = pk2(r[0], r[1]); o.y = pk2(r[2], r[3]); *(u32x2*)EPI_SLOT(ai, m, bj, n) = o; }
            EPI_BAR; EPI_WIDE_STORE(T, ldt, trow0, tcol0); EPI_BAR;
            return;
        }
        if (kind == 3) {
            EPI_WIDE_LOAD(T, ldt, trow0, tcol0); EPI_BAR;
#pragma unroll
            for (int ai = 0; ai < 2; ++ai)
#pragma unroll
                for (int m = 0; m < 4; ++m)
#pragma unroll
                    for (int bj = 0; bj < 2; ++bj)
#pragma unroll
                        for (int n = 0; n < 2; ++n) { const u32x2 t = *(const u32x2*)EPI_SLOT(ai, m, bj, n); const f32x4 v = acc[ai][bj][m][n];
                            u32x2 o; o.x = pk2(v[0] * bflo(t.x), v[1] * bfhi(t.x)); o.y = pk2(v[2] * bflo(t.y), v[3] * bfhi(t.y)); *(u32x2*)EPI_SLOT(ai, m, bj, n) = o; }
            EPI_BAR; EPI_WIDE_STORE(T, ldt, trow0, tcol0); EPI_BAR;
            return;
        }
#pragma unroll 1
        for (int ai = 0; ai < 2; ++ai) {
#pragma unroll 1
            for (int k2 = 0; k2 < 8; k2 += 2)
#pragma unroll
                for (int k = k2; k < k2 + 2; ++k) { const int pp = tid + 512 * k, row = pp >> 5, pc = pp & 31, slot = (2 * pc + 4 * (row & 15)) & 63; const int grow = brow + ai * HALF + row;
                    *(u32x4*)(L + row * 512 + slot * 8) = *(const u32x4*)(T + (size_t)(grow - trow0) * ldt + (bcol + pc * 8 - tcol0));
                    *(u32x4*)(L + 65536 + row * 512 + slot * 8) = *(const u32x4*)(S1 + (size_t)grow * ldc + bcol + pc * 8); }
            EPI_BAR;
#pragma unroll
            for (int m = 0; m < 4; ++m)
#pragma unroll
                for (int bj = 0; bj < 2; ++bj)
#pragma unroll
                    for (int n = 0; n < 2; ++n) { unsigned char* sl = L + (wr * 64 + m * 16 + fr) * 512 + ((bj * 32 + wc * 8 + n * 4 + fq + 4 * fr) & 63) * 8;
                        const u32x2 t = *(const u32x2*)sl, s1 = *(const u32x2*)(sl + 65536); const f32x4 v = ai == 0 ? acc[0][bj][m][n] : acc[1][bj][m][n];
                        u32x2 o; o.x = pk2(bflo(s1.x) + v[0] * bflo(t.x), bfhi(s1.x) + v[1] * bfhi(t.x)); o.y = pk2(bflo(s1.y) + v[2] * bflo(t.y), bfhi(s1.y) + v[3] * bfhi(t.y)); *(u32x2*)sl = o; }
            EPI_BAR;
#pragma unroll 1
            for (int k2 = 0; k2 < 8; k2 += 2)
#pragma unroll
                for (int k = k2; k < k2 + 2; ++k) { const int pp = tid + 512 * k, row = pp >> 5, pc = pp & 31, slot = (2 * pc + 4 * (row & 15)) & 63;
                    *(u32x4*)(O + (size_t)(brow + ai * HALF + row) * ldc + bcol + pc * 8) = *(const u32x4*)(L + row * 512 + slot * 8); }
            EPI_BAR;
        }
#undef EPI_BAR
#undef EPI_WIDE_LOAD
#undef EPI_WIDE_STORE
#undef EPI_SLOT
    }
};
DI void gemm_job(const Params& p, int job) {
    unsigned char* ws = p.ws;
    const bf16_t* A = nullptr; const bf16_t* Bt = nullptr; int N = 1024, K = 1024, npass = 1;
    EpiAny e; e.kind = 0; e.O = nullptr; e.ldc = DM; e.ncols = DM; e.T = nullptr; e.ldt = DM; e.trow0 = 0; e.tcol0 = 0; e.bias = p.b_gate; e.S1 = nullptr;
    if (job == 0)      { A = (const bf16_t*)(ws + WS_H);      Bt = (const bf16_t*)(ws + WS_WFFN1GU); N = 5632; K = 1024; e.kind = 1; e.O = (bf16_t*)(ws + WS_HFF1); }
    else if (job == 1) { A = (const bf16_t*)(ws + WS_HFF1);   Bt = (const bf16_t*)(ws + WS_WFFN1D);  N = 1024; K = 2816; e.O = (bf16_t*)(ws + WS_F1); }
    else if (job == 2) { A = (const bf16_t*)(ws + WS_H);      Bt = (const bf16_t*)(ws + WS_WIN);     N = NPCPAD; K = 1024; e.O = (bf16_t*)(ws + WS_P); e.ldc = NPC; e.ncols = NPC; }
    else if (job == 3) { N = 1024; npass = 4; e.O = (bf16_t*)(ws + WS_MERGED); e.S1 = (const bf16_t*)(ws + WS_MERGED); }
    else if (job == 4) { A = (const bf16_t*)(ws + WS_MERGED); Bt = (const bf16_t*)(ws + WS_WOUT);    N = 1024; K = 1024; e.O = (bf16_t*)(ws + WS_O); }
    else if (job == 5) { A = (const bf16_t*)(ws + WS_H3);     Bt = (const bf16_t*)(ws + WS_WFFN2GU); N = 5632; K = 1024; e.kind = 1; e.O = (bf16_t*)(ws + WS_HFF2); }
    else               { A = (const bf16_t*)(ws + WS_HFF2);   Bt = (const bf16_t*)(ws + WS_WFFN2D);  N = 1024; K = 2816; e.O = (bf16_t*)(ws + WS_F2); }
    const int nM = MTOK / BM, nN = N / BM;
    const bf16_t* H2 = (const bf16_t*)(ws + WS_H2B); const bf16_t* WGp = (const bf16_t*)(ws + WS_WG);
#define GDESC(q_, ok_, A_, Bt_, K_, brow_, bcol_, ps_) do { const int _i = (q_) / npass; ps_ = (q_) - _i * npass; int _pm, _pn; ok_ = tile_order(nM, nN, _i, gridDim.x, blockIdx.x, _pm, _pn); \
        brow_ = _pm * BM; bcol_ = _pn * BM; \
        if (job == 3) { A_ = (ps_ == 0 || ps_ == 2) ? H2 : (ps_ == 1 ? (const bf16_t*)(ws + WS_YA) : (const bf16_t*)(ws + WS_QB)); \
            Bt_ = ps_ == 0 ? WGp : (ps_ == 2 ? WGp + 1024ull * 1024 : (ps_ == 1 ? (const bf16_t*)(ws + WS_WA) : (const bf16_t*)(ws + WS_WB))); K_ = (ps_ & 1) ? 512 : 1024; } \
        else { A_ = A; Bt_ = Bt; K_ = K; } } while (0)
    bool ok, okn; const bf16_t* Ac; const bf16_t* Btc; int Kc, brow, bcol, ps; const bf16_t* An; const bf16_t* Btn; int Kn, brown, bcoln, psn;
    GDESC(0, ok, Ac, Btc, Kc, brow, bcol, ps);
    bool pre = false;
#pragma unroll 1
    for (int q = 0; ok; ++q) {
        GDESC(q + 1, okn, An, Btn, Kn, brown, bcoln, psn);
        if (job == 3) {
            const bool second = ps >= 2;
            e.kind = (ps == 0 || ps == 2) ? 2 : (ps == 1 ? 3 : 4);
            e.T = second ? (bf16_t*)(ws + WS_SCR) + (size_t)blockIdx.x * 65536 : (bf16_t*)(ws + WS_MERGED);
            e.ldt = second ? 256 : DM; e.trow0 = second ? brow : 0; e.tcol0 = second ? bcol : 0; e.bias = p.b_gate + (second ? 1024 : 0);
        }
        const bool hn = false;
        gemm_tile(Ac, Btc, Kc, brow, bcol, e, pre, hn, An, Btn, Kn, brown, bcoln);
        pre = hn; ok = okn; Ac = An; Btc = Btn; Kc = Kn; brow = brown; bcol = bcoln; ps = psn;
    }
#undef GDESC
}

DI void seq_of_token(int m, int& base, int& T, int& sq) { if (m < MPROMPT) { sq = m >> 13; base = sq << 13; T = TP; } else { const int s = (m - MPROMPT) >> 11; sq = 2 + s; base = MPROMPT + (s << 11); T = TS; } }
DI size_t vt_seq_off(int sq) { return sq < 2 ? (size_t)sq * 2 * 64 * TP : (size_t)2 * 2 * 64 * TP + (size_t)(sq - 2) * 2 * 64 * TS; }

DI void attn_prep_phase(const Params& p) {
    const int TID = tid_();
    const bf16_t* P = (const bf16_t*)(p.ws + WS_P);
    bf16_t* QB = (bf16_t*)(p.ws + WS_QB); bf16_t* KB = (bf16_t*)(p.ws + WS_KB); bf16_t* VT = (bf16_t*)(p.ws + WS_VT);
    const int wave = TID >> 6, lane = TID & 63, gw = blockIdx.x * 8 + wave, ngw = gridDim.x * 8;
    const int part = lane & 7, hsel = lane >> 3;
    float invf[4], gq[8], gk[8];
#pragma unroll
    for (int j = 0; j < 4; ++j) invf[j] = exp2f(-(float)((((part & 3) * 4 + j)) * 2) * (13.287712379549449f / 32.f)) * 0.15915494309189535f;
#pragma unroll
    for (int i = 0; i < 8; ++i) { gq[i] = p.qk_g[part * 8 + i]; gk[i] = p.qk_g[64 + part * 8 + i]; }
    for (int m4 = gw * 4; m4 < MTOK; m4 += ngw * 4) {
#pragma unroll
        for (int sub = 0; sub < 5; ++sub) {
            const bool isq = sub < 4;
            const int m = isq ? m4 + sub : m4 + (hsel >> 1), hd = isq ? hsel : (hsel & 1);
            int base, T, sq; seq_of_token(m, base, T, sq); const int t = m - base;
            const float pos = (part < 4) ? (float)(t >> 6) : (float)(t & 63);
            float x[8]; unpack8(*(const u32x4*)(P + (size_t)m * NPC + (isq ? 1920 : 2432) + hd * 64 + part * 8), x);
            float ss = 0.f;
#pragma unroll
            for (int i = 0; i < 8; ++i) ss += x[i] * x[i];
            ss = sum8_dpp(ss);
            const float rs = rsqrtf(ss * (1.f / 64.f) + 1e-6f);
            const float sc = isq ? 0.125f * 1.4426950408889634f : 1.f;
            float o[8];
#pragma unroll
            for (int j = 0; j < 4; ++j) {
                float rev = pos * invf[j]; rev -= rintf(rev);
                const float sn = __builtin_amdgcn_sinf(rev), cs = __builtin_amdgcn_cosf(rev);
                const float x0 = x[2 * j] * rs * (isq ? gq[2 * j] : gk[2 * j]), x1 = x[2 * j + 1] * rs * (isq ? gq[2 * j + 1] : gk[2 * j + 1]);
                o[2 * j] = (x0 * cs - x1 * sn) * sc; o[2 * j + 1] = (x0 * sn + x1 * cs) * sc;
            }
            bf16_t* dst = isq ? QB + (size_t)m * 512 + hd * 64 + part * 8 : KB + (size_t)m * 128 + hd * 64 + part * 8;
            *(u32x4*)dst = pack8(o);
        }
    }
    bf16_t* L = (bf16_t*)smem;
    for (int it = blockIdx.x; it < MTOK / 64; it += gridDim.x) {
        const int m0 = it * 64; int base, T, sq; seq_of_token(m0, base, T, sq); const int t0 = m0 - base;
        { const int t = TID >> 3, cgp = TID & 7; const bf16_t* src = P + (size_t)(m0 + t) * NPC + 2560 + cgp * 16;
          const u32x4 a = *(const u32x4*)src, b = *(const u32x4*)(src + 8);
          *(u32x4*)(L + t * 136 + cgp * 16) = a; *(u32x4*)(L + t * 136 + cgp * 16 + 8) = b; }
        __syncthreads();
        { const int dcol = TID >> 2, tq = TID & 3; float f[16];
#pragma unroll
          for (int i = 0; i < 16; ++i) f[i] = bf2f(L[(tq * 16 + i) * 136 + dcol]);
          bf16_t* dst = VT + vt_seq_off(sq) + ((size_t)(dcol >> 6) * 64 + (dcol & 63)) * T + t0 + tq * 16;
          *(u32x4*)dst = pack8(f); *(u32x4*)(dst + 8) = pack8(f + 8); }
        __syncthreads();
    }
}

DI void attn_item(const Params& p, int sq, int hq, int qb) {
    const int TID = tid_();
    bf16_t* QB = (bf16_t*)(p.ws + WS_QB); const bf16_t* KB = (const bf16_t*)(p.ws + WS_KB); const bf16_t* VT = (const bf16_t*)(p.ws + WS_VT);
    const int T = sq < 2 ? TP : TS, base = sq < 2 ? sq * TP : MPROMPT + (sq - 2) * TS, hk = hq >> 2;
    const int wave = __builtin_amdgcn_readfirstlane(TID >> 6), lane = TID & 63, r = lane & 31, h = lane >> 5;
    bf16_t* LK = (bf16_t*)smem;
    bf16_t* LV = LK + 2 * 64 * 72;
    const int mq = base + qb * 512 + wave * 64 + r;
    bf16x8 qf[2][4];
#pragma unroll
    for (int qq = 0; qq < 2; ++qq)
#pragma unroll
        for (int s = 0; s < 4; ++s) qf[qq][s] = *(const bf16x8*)(QB + (size_t)(mq + 32 * qq) * 512 + hq * 64 + 16 * s + 8 * h);
    const bf16_t* kg = KB + (size_t)base * 128 + hk * 64;
    const bf16_t* vg = VT + vt_seq_off(sq) + (size_t)hk * 64 * T;
    const int lr = TID >> 3, lc = (TID & 7) * 8;
    f32x16 oacc[2][2];
#pragma unroll
    for (int qq = 0; qq < 2; ++qq) for (int i = 0; i < 16; ++i) { oacc[qq][0][i] = 0.f; oacc[qq][1][i] = 0.f; }
    float mrun[2] = {0.f, 0.f}, lrun[2] = {0.f, 0.f}; bool shifted = false;
    const int nt = T / 64;
    u32x4 kreg = *(const u32x4*)(kg + (size_t)lr * 128 + lc), vreg = *(const u32x4*)(vg + (size_t)lr * T + lc);
    *(u32x4*)(LK + lr * 72 + lc) = kreg; *(u32x4*)(LV + lr * 72 + lc) = vreg;
    __syncthreads();
    for (int t = 0; t < nt; ++t) {
        const int cur = t & 1;
        if (t + 1 < nt) { kreg = *(const u32x4*)(kg + (size_t)((t + 1) * 64 + lr) * 128 + lc); vreg = *(const u32x4*)(vg + (size_t)lr * T + (t + 1) * 64 + lc); }
        const bf16_t* lk = LK + cur * 64 * 72; const bf16_t* lv = LV + cur * 64 * 72;
        f32x16 sc[2][2];
        __builtin_amdgcn_s_setprio(1);
#pragma unroll
        for (int kb = 0; kb < 2; ++kb) { for (int i = 0; i < 16; ++i) { sc[0][kb][i] = 0.f; sc[1][kb][i] = 0.f; }
#pragma unroll
            for (int s = 0; s < 4; ++s) { const bf16x8 kf = *(const bf16x8*)(lk + (kb * 32 + r) * 72 + 16 * s + 8 * h);
                sc[0][kb] = MFMA32(kf, qf[0][s], sc[0][kb]); sc[1][kb] = MFMA32(kf, qf[1][s], sc[1][kb]); } }
        __builtin_amdgcn_s_setprio(0);
        float mx[2];
#pragma unroll
        for (int qq = 0; qq < 2; ++qq) { float m = sc[qq][0][0];
#pragma unroll
            for (int i = 0; i < 16; ++i) { m = fmaxf(m, sc[qq][0][i]); m = fmaxf(m, sc[qq][1][i]); }
            mx[qq] = fmaxf(m, __shfl_xor(m, 32)); }
        const float dm0 = mx[0] - mrun[0], dm1 = mx[1] - mrun[1];
        if (__builtin_amdgcn_ballot_w64(dm0 > 24.f || dm1 > 24.f || (t == 0 && (dm0 < -24.f || dm1 < -24.f))) != 0ull) {
            shifted = true;
#pragma unroll
            for (int qq = 0; qq < 2; ++qq) {
                const float mnew = (t == 0) ? mx[qq] : fmaxf(mrun[qq], mx[qq]), alpha = (t == 0) ? 1.f : __builtin_amdgcn_exp2f(mrun[qq] - mnew);
                mrun[qq] = mnew; lrun[qq] *= alpha;
#pragma unroll
                for (int i = 0; i < 16; ++i) { oacc[qq][0][i] *= alpha; oacc[qq][1][i] *= alpha; } }
        }
        if (shifted) {
#pragma unroll
            for (int qq = 0; qq < 2; ++qq)
#pragma unroll
                for (int kb = 0; kb < 2; ++kb)
#pragma unroll
                    for (int i = 0; i < 16; ++i) sc[qq][kb][i] -= mrun[qq];
        }
#pragma unroll
        for (int qq = 0; qq < 2; ++qq) { float ps = 0.f;
#pragma unroll
            for (int kb = 0; kb < 2; ++kb)
#pragma unroll
                for (int i = 0; i < 16; ++i) { const float e = __builtin_amdgcn_exp2f(sc[qq][kb][i]); sc[qq][kb][i] = e; ps += e; }
            lrun[qq] += ps; }
        __builtin_amdgcn_s_setprio(1);
#pragma unroll
        for (int s2 = 0; s2 < 4; ++s2) {
            const bf16x8 pb0 = pack_step(sc[0][s2 >> 1], s2 & 1), pb1 = pack_step(sc[1][s2 >> 1], s2 & 1);
#pragma unroll
            for (int db = 0; db < 2; ++db) {
                const bf16_t* vp = lv + (db * 32 + r) * 72 + 16 * s2 + 4 * h;
                const s16x4 lo = *(const s16x4*)vp, hi = *(const s16x4*)(vp + 8);
                const bf16x8 vf = __builtin_shufflevector(lo, hi, 0, 1, 2, 3, 4, 5, 6, 7);
                oacc[0][db] = MFMA32(vf, pb0, oacc[0][db]); oacc[1][db] = MFMA32(vf, pb1, oacc[1][db]);
            }
        }
        __builtin_amdgcn_s_setprio(0);
        if (t + 1 < nt) { *(u32x4*)(LK + (cur ^ 1) * 64 * 72 + lr * 72 + lc) = kreg; *(u32x4*)(LV + (cur ^ 1) * 64 * 72 + lr * 72 + lc) = vreg; }
        __syncthreads();
    }
#pragma unroll
    for (int qq = 0; qq < 2; ++qq) {
        float l = lrun[qq]; l += __shfl_xor(l, 32);
        const float inv = 1.f / l;
        bf16_t* op = QB + (size_t)(mq + 32 * qq) * 512 + hq * 64;
#pragma unroll
        for (int db = 0; db < 2; ++db)
#pragma unroll
            for (int g = 0; g < 4; ++g) { u32x2 o; o.x = pk2(oacc[qq][db][4 * g] * inv, oacc[qq][db][4 * g + 1] * inv); o.y = pk2(oacc[qq][db][4 * g + 2] * inv, oacc[qq][db][4 * g + 3] * inv);
                *(u32x2*)(op + db * 32 + 8 * g + 4 * h) = o; }
    }
}
DI void attn_phase(const Params& p) {
    for (int it = blockIdx.x; it < 768; it += gridDim.x) {
        if (it < 256) { attn_item(p, it >> 7, (it >> 4) & 7, it & 15); }
        else { const int j = it - 256; attn_item(p, 2 + (j >> 5), (j >> 2) & 7, j & 3); }
    }
}

struct ScanItem { int d, h, T, tokbase, seg, nseg; };
DI ScanItem scan_item(int it) {
    ScanItem s;
    if (it < 512) { const int sc = it >> 4; s.seg = it & 15; s.nseg = 16; s.d = sc >> 4; s.h = sc & 7; s.T = TP; s.tokbase = ((sc >> 3) & 1) * TP; }
    else { const int j = it - 512, sc = j >> 3; s.seg = j & 7; s.nseg = 8; s.d = sc >> 7; s.h = sc & 7; s.T = TS; s.tokbase = MPROMPT + ((sc >> 3) & 15) * TS; }
    return s;
}
constexpr int P72 = 72, P40 = 40, PF = 68;
constexpr int RAW_B = 25600;
constexpr int O_RAW = 0, O_RT = RAW_B, O_KA = O_RT + 4608, O_KT = O_KA + 4608, O_BT = O_KT + 4608, O_KHT = O_BT + 4608, O_BHT = O_KHT + 5120, O_VTL = O_BHT + 5120,
              O_TW = O_KHT, O_AD = O_BHT,
              O_GAM = O_VTL + 5120, O_WTOT = O_GAM + 256, O_CONST = O_WTOT + 1024, O_U0 = O_CONST + 2560, O_WPRE = O_U0, O_APRE = O_U0 + 8704,
              O_APOW = O_U0, O_AAK = O_U0 + 5120, O_ARK = O_U0 + 7680, O_ARB = O_U0 + 10240, O_WM = O_U0 + 12800, GRP_LDS = O_U0 + 17408;
static_assert(GRP_LDS % 16 == 0 && 2 * GRP_LDS + 16 <= 160 * 1024, "LDS budget");
#define RBAR do { asm volatile("s_waitcnt lgkmcnt(0)" ::: "memory"); __builtin_amdgcn_s_barrier(); asm volatile("" ::: "memory"); } while (0)
DI bf16x8 lds_nat(const bf16_t* base, int row, int pitch, int s, int hh) { return *(const bf16x8*)(base + row * pitch + 16 * s + 8 * hh); }
DI bf16x8 lds_perm(const bf16_t* base, int row, int pitch, int s, int hh) {
    const bf16_t* q = base + row * pitch + 16 * s + 4 * hh; const s16x4 lo = *(const s16x4*)q, hi = *(const s16x4*)(q + 8);
    return __builtin_shufflevector(lo, hi, 0, 1, 2, 3, 4, 5, 6, 7);
}
DI bf16x8 lds_nat_sw(const bf16_t* base, int row, int s, int hh) { const int x = (row >> 3) & 3; return *(const bf16x8*)(base + row * P40 + (((2 * s + hh) ^ x) << 3)); }
DI bf16x8 lds_perm_sw(const bf16_t* base, int row, int s, int hh) {
    const int x = (row >> 3) & 3; const bf16_t* q = base + row * P40 + 4 * hh; const s16x4 lo = *(const s16x4*)(q + (((2 * s) ^ x) << 3)), hi = *(const s16x4*)(q + (((2 * s + 1) ^ x) << 3));
    return __builtin_shufflevector(lo, hi, 0, 1, 2, 3, 4, 5, 6, 7);
}
DI void load_shift8(const bf16_t* P, const float* mu, int m, int col, bool hp, bool hn, float* x) {
    const bf16_t* q = P + (size_t)m * NPC + col;
    float a[8], b[8], c[8]; unpack8(*(const u32x4*)q, a);
    const u32x4 z = {0u, 0u, 0u, 0u};
    unpack8(hp ? *(const u32x4*)(q - NPC) : z, b); unpack8(hn ? *(const u32x4*)(q + NPC) : z, c);
    const f32x4 m0 = *(const f32x4*)(mu + col), m1 = *(const f32x4*)(mu + col + 4);
#pragma unroll
    for (int i = 0; i < 8; ++i) { const float mm = i < 4 ? m0[i & 3] : m1[i & 3]; x[i] = a[i] + (0.5f * (b[i] + c[i]) - a[i]) * mm; }
}

DI void rwkv_prefetch(const bf16_t* P, unsigned char* RAWL, const ScanItem& si, int tau0, int gw, int lane) {
    int ln = lane; asm volatile("" : "+v"(ln));
    const int r8 = ln >> 3, sub = ln & 7;
#pragma unroll
    for (int r = 0; r < 7; ++r) {
        int inst = r * 4 + gw; inst = inst > 24 ? 24 : inst;
        const int cg = inst / 5, rb = inst - cg * 5;
        int tau = tau0 - 1 + rb * 8 + r8; tau = tau < 0 ? 0 : (tau > si.T - 1 ? si.T - 1 : tau);
        const int tok = si.d ? si.T - 1 - tau : tau;
        const int colb = (cg < 3 ? cg * 512 + si.h * 64 : (cg == 3 ? 1536 : 1664) + si.d * 64);
        __builtin_amdgcn_global_load_lds((const unsigned*)(P + (size_t)(si.tokbase + tok) * NPC + colb + sub * 8), (unsigned*)(RAWL + inst * 1024), 16, 0, 0);
    }
}

DI void rwkv_pass(const Params& p, const int PASS) {
    const int TID = tid_();
    const bf16_t* P = (const bf16_t*)(p.ws + WS_P);
    float* NB = (float*)(p.ws + WS_NBUF); float* PB = (float*)(p.ws + WS_PBUF);
    bf16_t* YD = (bf16_t*)(p.ws + WS_YDIR); float* COEF = (float*)(p.ws + WS_COEF);
    const bf16_t* WUPT = (const bf16_t*)(p.ws + WS_WUPT); const bf16_t* AUPT = (const bf16_t*)(p.ws + WS_AUPT);
    const int wave = __builtin_amdgcn_readfirstlane(TID >> 6), lane = TID & 63, grp = wave >> 2, pw = wave & 3, gw = (pw + 2 * grp) & 3, gtid = TID & 255;
    const int c = lane & 31, hh = lane >> 5;
    unsigned char* L = smem + grp * GRP_LDS;
    bf16_t* TW = (bf16_t*)(L + O_TW); bf16_t* AD = (bf16_t*)(L + O_AD); bf16_t* RT = (bf16_t*)(L + O_RT); bf16_t* KA = (bf16_t*)(L + O_KA);
    bf16_t* KT = (bf16_t*)(L + O_KT); bf16_t* BT = (bf16_t*)(L + O_BT); bf16_t* KHT = (bf16_t*)(L + O_KHT); bf16_t* BHT = (bf16_t*)(L + O_BHT);
    bf16_t* VTL = (bf16_t*)(L + O_VTL); float* GAM = (float*)(L + O_GAM); float* WTOT = (float*)(L + O_WTOT);
    float* CONSTL = (float*)(L + O_CONST); unsigned char* RAWL = L + O_RAW;
    float* WPRE = (float*)(L + O_WPRE); float* APRE = (float*)(L + O_APRE);
    bf16_t* APOW = (bf16_t*)(L + O_APOW); bf16_t* AAK = (bf16_t*)(L + O_AAK); bf16_t* ARK = (bf16_t*)(L + O_ARK); bf16_t* ARB = (bf16_t*)(L + O_ARB); bf16_t* WM = (bf16_t*)(L + O_WM);
    const int et = gtid >> 3, jg = gtid & 7;
    const int etsw = ((((et >> 3) ^ (jg & 3))) << 3) | (et & 7);
    const bool isS = gw >= 2; const int tile = gw & 1;

    for (int pair = blockIdx.x; pair < 1280; pair += gridDim.x) {
        const int item = pair * 2 + grp; const ScanItem si = scan_item(item);
        const int hj = si.h * 64 + jg * 8;
        for (int q = gtid; q < 640; q += 256) {
            const int j = q & 63; float v;
            if (q < 320) { const int arr = q >> 6; const float* src = arr == 0 ? p.w0 + si.d * 512 : (arr == 1 ? p.a0 + si.d * 512 : (arr == 2 ? p.k_k : (arr == 3 ? p.k_a : p.r_k))); v = src[si.h * 64 + j]; }
            else { const int cg = (q - 320) >> 6; v = p.mu[(cg < 3 ? cg * 512 + si.h * 64 : (cg == 3 ? 1536 : 1664) + si.d * 64) + j]; }
            CONSTL[q] = v; }
        const int nch = si.nseg == 16 ? 16 : 8;
        rwkv_prefetch(P, RAWL, si, si.seg * nch * 32, gw, lane);
        f32x16 XT[2];
#pragma unroll
        for (int jt = 0; jt < 2; ++jt)
#pragma unroll
            for (int i = 0; i < 16; ++i) XT[jt][i] = 0.f;
        int lnI = lane; asm volatile("" : "+v"(lnI)); const int cI = lnI & 31, hhI = lnI >> 5;
        const int idc_ = 32 * tile + cI - 4 * hhI;
        if (PASS == 0) { if (!isS) {
#pragma unroll
            for (int jt = 0; jt < 2; ++jt)
#pragma unroll
                for (int i = 0; i < 16; ++i) XT[jt][i] = (32 * jt + crow(i, 0) == idc_) ? 1.f : 0.f; } }
        else { if (isS && si.seg > 0) { const int lo_ = 4 * hhI * 64 + 32 * tile + cI; const float* src = NB + (size_t)(item - 1) * 4096 + lo_;
#pragma unroll
            for (int jt = 0; jt < 2; ++jt)
#pragma unroll
                for (int i = 0; i < 16; ++i) XT[jt][i] = src[(32 * jt + crow(i, 0)) * 64]; } }

#pragma unroll 1
        for (int ch = 0; ch < nch; ++ch) {
            const int tau0 = si.seg * nch * 32 + ch * 32;
            asm volatile("s_waitcnt vmcnt(0)" ::: "memory");
            RBAR;
            float rr[8], kx[8], vv[8];
            bf16x8 bfr[4];
            { int lnC = lane; asm volatile("" : "+v"(lnC));
              const bf16_t* up = ((gw >> 1) ? AUPT : WUPT) + ((size_t)(si.d * 512 + si.h * 64 + 32 * (gw & 1) + (lnC & 31))) * 64 + 8 * (lnC >> 5);
#pragma unroll
              for (int s = 0; s < 4; ++s) bfr[s] = *(const bf16x8*)(up + 16 * s); }
            { const int tau = tau0 + et; const bool vlo = tau > 0, vhi = tau < si.T - 1;
              int lnS = lane; asm volatile("" : "+v"(lnS));
              float wd[8], ad[8];
#pragma unroll
              for (int cg = 0; cg < 5; ++cg) {
                  const int etc = pw * 8 + (lnS >> 3), jgc = lnS & 7;
                  const int r0 = etc, r1 = etc + 1, r2 = etc + 2;
                  const unsigned char* qb = RAWL + (cg * 5 * 64 + jgc) * 16;
                  const unsigned char* q0 = qb + ((r0 >> 3) * 64 + (r0 & 7) * 8) * 16; const unsigned char* q = qb + ((r1 >> 3) * 64 + (r1 & 7) * 8) * 16; const unsigned char* q2 = qb + ((r2 >> 3) * 64 + (r2 & 7) * 8) * 16;
                  const u32x4 z4 = {0u, 0u, 0u, 0u};
                  float a[8], b[8], cc[8]; unpack8(*(const u32x4*)q, a); unpack8(vlo ? *(const u32x4*)q0 : z4, b); unpack8(vhi ? *(const u32x4*)q2 : z4, cc);
                  const f32x4 m0 = *(const f32x4*)(CONSTL + 320 + cg * 64 + jg * 8), m1 = *(const f32x4*)(CONSTL + 320 + cg * 64 + jg * 8 + 4);
                  float* x = cg == 0 ? rr : (cg == 1 ? kx : (cg == 2 ? vv : (cg == 3 ? wd : ad)));
#pragma unroll
                  for (int i = 0; i < 8; ++i) { const float mm = i < 4 ? m0[i & 3] : m1[i & 3]; x[i] = a[i] + (0.5f * (b[i] + cc[i]) - a[i]) * mm; }
              }
#pragma unroll
              for (int i = 0; i < 8; ++i) wd[i] = tanhf_(wd[i]);
              *(u32x4*)(TW + et * P72 + jg * 8) = pack8(wd); *(u32x4*)(AD + et * P72 + jg * 8) = pack8(ad); }
            asm volatile("" :: "v"(bfr[0]), "v"(bfr[1]), "v"(bfr[2]), "v"(bfr[3]));
            RBAR;
            rwkv_prefetch(P, RAWL, si, tau0 + 32, gw, lane);
            { f32x16 acc; for (int i = 0; i < 16; ++i) acc[i] = 0.f;
              const bf16_t* Asrc = (gw >> 1) ? AD : TW;
#pragma unroll
              for (int s = 0; s < 4; ++s) acc = MFMA32(lds_nat(Asrc, c, P72, s, hh), bfr[s], acc);
              float* dst = ((gw >> 1) ? APRE : WPRE) + 32 * (gw & 1) + c;
#pragma unroll
              for (int i = 0; i < 16; ++i) dst[crow(i, hh) * PF] = acc[i]; }
            RBAR;
            { float cl[8], lw[8], av[8], kk[8], kd[8];
#pragma unroll
              for (int i = 0; i < 8; ++i) VTL[(jg * 8 + i) * P40 + etsw] = f2bf(vv[i]);
              float ss = 0.f, cf = 0.f;
              { const f32x4 wp0 = *(const f32x4*)(WPRE + et * PF + jg * 8), wp1 = *(const f32x4*)(WPRE + et * PF + jg * 8 + 4);
                const f32x4 ap0 = *(const f32x4*)(APRE + et * PF + jg * 8), ap1 = *(const f32x4*)(APRE + et * PF + jg * 8 + 4);
#pragma unroll
                for (int i = 0; i < 8; ++i) {
                  const float wpre = (i < 4 ? wp0[i & 3] : wp1[i & 3]) + CONSTL[jg * 8 + i];
                  const float apre = (i < 4 ? ap0[i & 3] : ap1[i & 3]) + CONSTL[64 + jg * 8 + i];
                  lw[i] = -0.60653065971263342f * sigmoidf_(wpre);
                  av[i] = sigmoidf_(apre);
                  kk[i] = kx[i] * CONSTL[128 + jg * 8 + i]; ss += kk[i] * kk[i];
                  kd[i] = kx[i] * (1.f + (av[i] - 1.f) * CONSTL[192 + jg * 8 + i]);
                  cf += rr[i] * kd[i] * CONSTL[256 + jg * 8 + i];
                } }
              ss = sum8_dpp(ss);
              const float inv = __builtin_amdgcn_rsqf(fmaxf(ss, 1e-24f));
              if (PASS == 1) { cf = sum8_dpp(cf);
                  if (jg == 0) { const int tau = tau0 + et, tok = si.d ? si.T - 1 - tau : tau; COEF[((size_t)si.d * MTOK + si.tokbase + tok) * 8 + si.h] = cf; } }
#pragma unroll
              for (int i = 0; i < 8; ++i) { kk[i] *= inv; cl[i] = lw[i]; }
#pragma unroll
              for (int dlt = 8; dlt < 64; dlt <<= 1) {
#pragma unroll
                  for (int i = 0; i < 8; ++i) { const float o = __shfl_up(cl[i], dlt); if (lane >= dlt) cl[i] += o; } }
              if (lane >= 56) {
#pragma unroll
                  for (int i = 0; i < 8; ++i) WTOT[pw * 64 + jg * 8 + i] = cl[i]; }
              RBAR;
              float tot[8];
#pragma unroll
              for (int i = 0; i < 8; ++i) { float pre = 0.f, t4 = 0.f;
#pragma unroll
                  for (int w = 0; w < 4; ++w) { const float x = WTOT[w * 64 + jg * 8 + i]; t4 += x; if (w < pw) pre += x; }
                  cl[i] += pre; tot[i] = t4; }
              { float o[8];
                if (PASS == 1) {
#pragma unroll
                    for (int i = 0; i < 8; ++i) o[i] = rr[i] * __expf(cl[i]);
                    *(u32x4*)(RT + et * P72 + jg * 8) = pack8(o); }
#pragma unroll
                for (int i = 0; i < 8; ++i) o[i] = kk[i] * __expf(cl[i] - lw[i]);
                *(u32x4*)(KA + et * P72 + jg * 8) = pack8(o); }
              { float en[8], o[8];
#pragma unroll
                for (int i = 0; i < 8; ++i) { en[i] = __expf(-cl[i]); o[i] = kd[i] * en[i]; }
                *(u32x4*)(KT + et * P72 + jg * 8) = pack8(o);
#pragma unroll
                for (int i = 0; i < 8; ++i) o[i] = kk[i] * av[i] * en[i];
                *(u32x4*)(BT + et * P72 + jg * 8) = pack8(o); }
#pragma unroll
              for (int i = 0; i < 8; ++i) { const float eh = __expf(tot[i] - cl[i]);
                  KHT[(jg * 8 + i) * P40 + etsw] = f2bf(kd[i] * eh); BHT[(jg * 8 + i) * P40 + etsw] = f2bf(kk[i] * av[i] * eh); }
              if (et == 0) {
#pragma unroll
                  for (int i = 0; i < 8; ++i) GAM[jg * 8 + i] = __expf(tot[i]); }
            }
            RBAR;
            f32x16 apw;
            if (PASS == 1 || gw < 2) { const bf16_t* Am = (gw < 2) ? KA : RT; const bf16_t* Bm = (gw == 0 || gw == 3) ? BT : KT;
              f32x16 acc; for (int i = 0; i < 16; ++i) acc[i] = 0.f;
#pragma unroll
              for (int s = 0; s < 4; ++s) acc = MFMA32(lds_nat(Am, c, P72, s, hh), lds_nat(Bm, c, P72, s, hh), acc);
              bf16_t* dst = gw == 0 ? APOW : (gw == 1 ? AAK : (gw == 2 ? ARK : ARB));
#pragma unroll
              for (int i = 0; i < 16; ++i) { const int t = crow(i, hh); const bool keep = (gw < 2) ? (c < t) : (c <= t); acc[i] = keep ? acc[i] : 0.f; dst[t * P40 + c] = f2bf(acc[i]); }
              apw = acc; }
            RBAR;
            f32x16 rhs;
            if (gw < 2) {
#pragma unroll
                for (int i = 0; i < 16; ++i) rhs[i] = bf2f(KA[crow(i, hh) * P72 + 32 * gw + c]);
            } else { for (int i = 0; i < 16; ++i) rhs[i] = 0.f;
#pragma unroll
                for (int s2 = 0; s2 < 2; ++s2) rhs = MFMA32(lds_nat(AAK, c, P40, s2, hh), lds_nat_sw(VTL, 32 * tile + c, s2, hh), rhs);
#pragma unroll
                for (int i = 0; i < 16; ++i) rhs[i] = -rhs[i]; }
#pragma unroll
            for (int k = 0; k < 5; ++k) {
                const bf16_t* Ap = APOW + (k & 1) * 32 * P40;
                f32x16 dl; for (int i = 0; i < 16; ++i) dl[i] = 0.f;
#pragma unroll
                for (int s2 = 0; s2 < 2; ++s2) dl = MFMA32(lds_perm(Ap, c, P40, s2, hh), pack_step(rhs, s2), dl);
                if (k == 0) { for (int i = 0; i < 16; ++i) rhs[i] -= dl[i]; } else { for (int i = 0; i < 16; ++i) rhs[i] += dl[i]; }
                if (k < 4 && gw == 0) {
                    f32x16 nx; for (int i = 0; i < 16; ++i) nx[i] = 0.f;
#pragma unroll
                    for (int s2 = 0; s2 < 2; ++s2) nx = MFMA32(lds_perm(Ap, c, P40, s2, hh), pack_step(apw, s2), nx);
                    bf16_t* An = APOW + ((k + 1) & 1) * 32 * P40;
#pragma unroll
                    for (int i = 0; i < 16; ++i) An[crow(i, hh) * P40 + c] = f2bf(nx[i]);
                    apw = nx;
                }
                RBAR;
            }
            if (gw < 2) {
#pragma unroll
                for (int i = 0; i < 16; ++i) WM[crow(i, hh) * P72 + 32 * gw + c] = f2bf(rhs[i]); }
            RBAR;
            if (PASS == 0 || isS) {
                bf16x8 xb[4];
#pragma unroll
                for (int s = 0; s < 4; ++s) xb[s] = pack_step(XT[s >> 1], s & 1);
                f32x16 g; for (int i = 0; i < 16; ++i) g[i] = 0.f;
#pragma unroll
                for (int s = 0; s < 4; ++s) g = MFMA32(lds_perm(WM, c, P72, s, hh), xb[s], g);
                f32x16 z;
                if (isS) { for (int i = 0; i < 16; ++i) z[i] = rhs[i] - g[i]; } else { for (int i = 0; i < 16; ++i) z[i] = -g[i]; }
                bf16x8 zb[2]; zb[0] = pack_step(z, 0); zb[1] = pack_step(z, 1);
                bf16x8 vf[2];
                if (isS) { vf[0] = lds_nat_sw(VTL, 32 * tile + c, 0, hh); vf[1] = lds_nat_sw(VTL, 32 * tile + c, 1, hh); }
                if (PASS == 1) {
                    f32x16 y; for (int i = 0; i < 16; ++i) y[i] = 0.f;
#pragma unroll
                    for (int s = 0; s < 4; ++s) y = MFMA32(lds_perm(RT, c, P72, s, hh), xb[s], y);
#pragma unroll
                    for (int s2 = 0; s2 < 2; ++s2) { y = MFMA32(lds_nat(ARK, c, P40, s2, hh), vf[s2], y); y = MFMA32(lds_perm(ARB, c, P40, s2, hh), zb[s2], y); }
                    { const int tok0 = si.d ? si.T - 1 - tau0 - 4 * hh : tau0 + 4 * hh; const long rstride = si.d ? -512 : 512;
                      bf16_t* yp = YD + ((size_t)si.d * MTOK + si.tokbase + tok0) * 512 + si.h * 64 + 32 * tile + c;
#pragma unroll
                      for (int i = 0; i < 16; ++i) yp[rstride * crow(i, 0)] = f2bf(y[i]); }
                }
#pragma unroll
                for (int jt = 0; jt < 2; ++jt) {
                    f32x16 nx;
#pragma unroll
                    for (int g4 = 0; g4 < 4; ++g4) { const f32x4 gm = *(const f32x4*)(GAM + 32 * jt + 8 * g4 + 4 * hh);
#pragma unroll
                        for (int j = 0; j < 4; ++j) nx[4 * g4 + j] = XT[jt][4 * g4 + j] * gm[j]; }
#pragma unroll
                    for (int s2 = 0; s2 < 2; ++s2) {
                        nx = MFMA32(lds_perm_sw(BHT, 32 * jt + c, s2, hh), zb[s2], nx);
                        if (isS) nx = MFMA32(lds_nat_sw(KHT, 32 * jt + c, s2, hh), vf[s2], nx);
                    }
                    XT[jt] = nx;
                }
            }
        }
        if (PASS == 0) { int lnE = lane; asm volatile("" : "+v"(lnE)); const int lo_ = 4 * (lnE >> 5) * 64 + 32 * tile + (lnE & 31);
            if (isS) { float* dst = NB + (size_t)item * 4096 + lo_;
#pragma unroll
                for (int jt = 0; jt < 2; ++jt)
#pragma unroll
                    for (int i = 0; i < 16; ++i) dst[(32 * jt + crow(i, 0)) * 64] = XT[jt][i]; }
            else { bf16_t* dst = (bf16_t*)PB + (size_t)item * 4096 + lo_;
#pragma unroll
                for (int jt = 0; jt < 2; ++jt)
#pragma unroll
                    for (int i = 0; i < 16; ++i) dst[(32 * jt + crow(i, 0)) * 64] = f2bf(XT[jt][i]); } }
        RBAR;
    }
}

DI void rwkv_chain(const Params& p) {
    const int TID = tid_();
    float* NB = (float*)(p.ws + WS_NBUF); const bf16_t* PBh = (const bf16_t*)(p.ws + WS_PBUF);
    const int wave = TID >> 6, lane = TID & 63, c = lane & 31, hh = lane >> 5;
    const int G = gridDim.x; const bool split = G >= 128;
    int task0, tstep, tend;
    if (!split) { task0 = wave * G + blockIdx.x; tstep = G * 8; tend = 576; }
    else if ((int)blockIdx.x < 64) { task0 = wave == 0 ? (int)blockIdx.x : 576; tstep = 576; tend = 576; }
    else { task0 = 64 + ((int)blockIdx.x - 64) + (G - 64) * wave; tstep = (G - 64) * 8; tend = 576; }
    for (int task = task0; task < tend; task += tstep) {
        const int sc = task >> 1, tile = task & 1;
        const int nseg = sc < 32 ? 16 : 8, item0 = sc < 32 ? sc * 16 : 512 + (sc - 32) * 8;
        f32x16 XT[2];
        for (int jt = 0; jt < 2; ++jt) for (int i = 0; i < 16; ++i) XT[jt][i] = 0.f;
        bf16x8 pn[2][4]; f32x16 nq[2];
#define CH_LOAD(sg_) do { const bf16_t* Pm_ = PBh + (size_t)(item0 + (sg_)) * 4096; const float* Nm_ = NB + (size_t)(item0 + (sg_)) * 4096 + 4 * hh * 64 + 32 * tile + c; \
        _Pragma("unroll") for (int jt = 0; jt < 2; ++jt) { _Pragma("unroll") for (int s = 0; s < 4; ++s) { \
            const bf16_t* q = Pm_ + (32 * jt + c) * 64 + 16 * s + 4 * hh; const s16x4 lo = *(const s16x4*)q, hi = *(const s16x4*)(q + 8); \
            pn[jt][s] = __builtin_shufflevector(lo, hi, 0, 1, 2, 3, 4, 5, 6, 7); } \
            _Pragma("unroll") for (int i = 0; i < 16; ++i) nq[jt][i] = Nm_[(32 * jt + crow(i, 0)) * 64]; } } while (0)
        CH_LOAD(0);
#pragma unroll 1
        for (int sg = 0; sg < nseg - 1; ++sg) {
            float* Nm = NB + (size_t)(item0 + sg) * 4096 + 4 * hh * 64 + 32 * tile + c;
            f32x16 nn[2]; nn[0] = nq[0]; nn[1] = nq[1];
            bf16x8 pa[2][4], xb[4];
#pragma unroll
            for (int jt = 0; jt < 2; ++jt)
#pragma unroll
                for (int s = 0; s < 4; ++s) pa[jt][s] = pn[jt][s];
            if (sg + 1 < nseg - 1) CH_LOAD(sg + 1);
#pragma unroll
            for (int s = 0; s < 4; ++s) xb[s] = pack_step(XT[s >> 1], s & 1);
#pragma unroll
            for (int jt = 0; jt < 2; ++jt) {
                f32x16 nx; for (int i = 0; i < 16; ++i) nx[i] = 0.f;
#pragma unroll
                for (int s = 0; s < 4; ++s) nx = MFMA32(pa[jt][s], xb[s], nx);
#pragma unroll
                for (int i = 0; i < 16; ++i) { XT[jt][i] = nx[i] + nn[jt][i]; Nm[(32 * jt + crow(i, 0)) * 64] = XT[jt][i]; }
            }
        }
#undef CH_LOAD
    }
}

DI void ypost_phase(const Params& p) {
    const int TID = tid_();
    const bf16_t* P = (const bf16_t*)(p.ws + WS_P); const bf16_t* YD = (const bf16_t*)(p.ws + WS_YDIR); const float* COEF = (const float*)(p.ws + WS_COEF);
    const bf16_t* GUPT = (const bf16_t*)(p.ws + WS_GUPT); bf16_t* YA = (bf16_t*)(p.ws + WS_YA);
    bf16_t* SG = (bf16_t*)smem;
    float* GL = (float*)(smem + 16384);
    const int w = __builtin_amdgcn_readfirstlane(TID >> 6), lane = TID & 63, c = lane & 31, hh = lane >> 5;
    bf16x8 gf[2][8];
#pragma unroll
    for (int q = 0; q < 2; ++q)
#pragma unroll
        for (int s = 0; s < 8; ++s) gf[q][s] = *(const bf16x8*)(GUPT + (size_t)(w * 64 + 32 * q + c) * 128 + 16 * s + 8 * hh);
    const int et = TID >> 4, e16 = TID & 15;
    for (int item = blockIdx.x; item < MTOK / 32; item += gridDim.x) {
        const int m0 = item * 32; int base, T, sq; seq_of_token(m0, base, T, sq);
        { const int m = m0 + et, tok = m - base; float x[8];
          load_shift8(P, p.mu, m, 1792 + e16 * 8, tok > 0, tok < T - 1, x);
#pragma unroll
          for (int i = 0; i < 8; ++i) x[i] = sigmoidf_(x[i]);
          *(u32x4*)(SG + et * 136 + e16 * 8) = pack8(x); }
        __syncthreads();
#pragma unroll
        for (int q = 0; q < 2; ++q) { f32x16 g; for (int i = 0; i < 16; ++i) g[i] = 0.f;
#pragma unroll
            for (int s = 0; s < 8; ++s) g = MFMA32(lds_nat(SG, c, 136, s, hh), gf[q][s], g);
#pragma unroll
            for (int i = 0; i < 16; ++i) GL[crow(i, hh) * 516 + w * 64 + 32 * q + c] = g[i]; }
        __syncthreads();
        { const int m = m0 + et, tok = m - base; const bool hp = tok > 0, hn = tok < T - 1;
#pragma unroll
          for (int k = 0; k < 4; ++k) {
              const int fg = e16 + 16 * k, f0 = fg * 8, head = fg >> 3;
              float y0[8], y1[8], x[8];
              unpack8(*(const u32x4*)(YD + (size_t)m * 512 + f0), y0); unpack8(*(const u32x4*)(YD + ((size_t)MTOK + m) * 512 + f0), y1);
              load_shift8(P, p.mu, m, 1024 + f0, hp, hn, x);
              const float cf = COEF[(size_t)m * 8 + head] + COEF[((size_t)MTOK + m) * 8 + head];
              const f32x4 g0 = *(const f32x4*)(GL + et * 516 + f0), g1 = *(const f32x4*)(GL + et * 516 + f0 + 4);
              const f32x4 w0 = *(const f32x4*)(p.lnx_w + f0), w1 = *(const f32x4*)(p.lnx_w + f0 + 4), b0 = *(const f32x4*)(p.lnx_b + f0), b1 = *(const f32x4*)(p.lnx_b + f0 + 4);
              float sm = 0.f;
#pragma unroll
              for (int i = 0; i < 8; ++i) { y0[i] += y1[i]; sm += y0[i]; }
              sm = sum8_dpp(sm);
              const float mean = sm * (1.f / 64.f); float vs = 0.f;
#pragma unroll
              for (int i = 0; i < 8; ++i) { y0[i] -= mean; vs += y0[i] * y0[i]; }
              vs = sum8_dpp(vs);
              const float rstd = rsqrtf(vs * (1.f / 64.f) + 64e-5f);
              float o[8];
#pragma unroll
              for (int i = 0; i < 8; ++i) { const float lw_ = i < 4 ? w0[i & 3] : w1[i & 3], lb_ = i < 4 ? b0[i & 3] : b1[i & 3], gg = i < 4 ? g0[i & 3] : g1[i & 3];
                  o[i] = (y0[i] * rstd * lw_ + lb_ + cf * x[i]) * gg; }
              *(u32x4*)(YA + (size_t)m * 512 + f0) = pack8(o);
          } }
        __syncthreads();
    }
}

DI void prologue_phase(const Params& p) {
    const int TID = tid_();
    const int wave = TID >> 6, lane = TID & 63, gw = blockIdx.x * 8 + wave, ngw = gridDim.x * 8;
    float* scr = (float*)smem + wave * (64 * 33);
    unsigned char* ws = p.ws;
    { u32x4* z = (u32x4*)(ws + WS_WIN + 2688ull * 1024 * 2); const u32x4 zero = {0u, 0u, 0u, 0u};
      for (int i = blockIdx.x * 512 + TID; i < 128 * 1024 * 2 / 16; i += gridDim.x * 512) z[i] = zero; }
    constexpr int I_GU = (1024 / 64) * (2816 / 32), I_D = (2816 / 64) * (1024 / 32), I_IN = (1024 / 64) * (2688 / 32), I_G = (1024 / 64) * (2048 / 32),
                  I_BR = (512 / 64) * (1024 / 32), I_OUT = (1024 / 64) * (1024 / 32), I_LU = 1 * (512 / 32), I_GL = 2 * (512 / 32);
    constexpr int NITEMS = 4 * I_GU + 2 * I_D + I_IN + I_G + 2 * I_BR + I_OUT + 4 * I_LU + I_GL;
    for (int it = gw; it < NITEMS; it += ngw) {
        int r = it; TJob j; bool found = false;
#define TRY(cnt, W_, ldw_, K_, c0_, nc_, WT_, dr_, mode_) if (!found) { if (r < (cnt)) { j.W = (W_); j.ldw = (ldw_); j.K = (K_); j.ncol0 = (c0_); j.ncols = (nc_); j.WT = (bf16_t*)(WT_); j.dstrow0 = (dr_); j.mode = (mode_); found = true; } else r -= (cnt); }
        TRY(I_GU, p.ffn_wg, 2816, 1024, 0, 2816, ws + WS_WFFN1GU, 0, 1)
        TRY(I_GU, p.ffn_wu, 2816, 1024, 0, 2816, ws + WS_WFFN1GU, 0, 2)
        TRY(I_D, p.ffn_wd, 1024, 2816, 0, 1024, ws + WS_WFFN1D, 0, 0)
        TRY(I_GU, p.ffn_wg + 1024ull * 2816, 2816, 1024, 0, 2816, ws + WS_WFFN2GU, 0, 1)
        TRY(I_GU, p.ffn_wu + 1024ull * 2816, 2816, 1024, 0, 2816, ws + WS_WFFN2GU, 0, 2)
        TRY(I_D, p.ffn_wd + 2816ull * 1024, 1024, 2816, 0, 1024, ws + WS_WFFN2D, 0, 0)
        TRY(I_IN, p.w_in, 4736, 1024, 0, 2688, ws + WS_WIN, 0, 0)
        TRY(I_G, p.w_in, 4736, 1024, 2688, 2048, ws + WS_WG, 0, 0)
        TRY(I_BR, p.w_ba, 1024, 512, 0, 1024, ws + WS_WA, 0, 0)
        TRY(I_BR, p.w_bb, 1024, 512, 0, 1024, ws + WS_WB, 0, 0)
        TRY(I_OUT, p.w_out, 1024, 1024, 0, 1024, ws + WS_WOUT, 0, 0)
        TRY(I_LU, p.w_up, 512, 64, 0, 512, ws + WS_WUPT, 0, 0)
        TRY(I_LU, p.w_up + 64 * 512, 512, 64, 0, 512, ws + WS_WUPT, 512, 0)
        TRY(I_LU, p.a_up, 512, 64, 0, 512, ws + WS_AUPT, 0, 0)
        TRY(I_LU, p.a_up + 64 * 512, 512, 64, 0, 512, ws + WS_AUPT, 512, 0)
        TRY(I_GL, p.g_up, 512, 128, 0, 512, ws + WS_GUPT, 0, 0)
#undef TRY
        if (found) tjob_run(j, r, scr, lane);
    }
    row_phase(p, 0, nullptr, 0.f, nullptr, p.norm_g, (bf16_t*)(ws + WS_H), gw, ngw, lane);
}

DI void row_job(const Params& p, int rowm) {
    const int TID = tid_();
    unsigned char* ws = p.ws;
    const int wave = TID >> 6, lane = TID & 63, gw = blockIdx.x * 8 + wave, ngw = gridDim.x * 8;
    const int mode = rowm == 0 ? 1 : (rowm == 1 ? 3 : 2);
    const bf16_t* f = rowm == 0 ? (const bf16_t*)(ws + WS_F1) : (rowm == 2 ? (const bf16_t*)(ws + WS_O) : (const bf16_t*)(ws + WS_F2));
    const float scale = rowm == 2 ? 1.0f : 0.5f;
    const float* gpost = p.norm_g + (rowm == 0 ? 1 : (rowm == 2 ? 3 : 5)) * DM;
    const float* gpre = p.norm_g + (rowm == 2 ? 4 : 2) * DM;
    bf16_t* hb = rowm == 0 ? (bf16_t*)(ws + WS_H) : (rowm == 1 ? (bf16_t*)(ws + WS_H2B) : (rowm == 2 ? (bf16_t*)(ws + WS_H3) : nullptr));
    row_phase(p, mode, f, scale, gpost, gpre, hb, gw, ngw, lane);
}

#define XB_TMO      128
#define XB_XCNT(j)  (256  + 64 * (j))
#define XB_XSUB(j)  (1280 + 64 * (j))
#define XB_XGEN(j)  (2304 + 64 * (j))
#define XB_TOP      3328
#define XB_TOPGEN   3392
#define XCD_BAR_WORDS 3456
#define XB_SPIN_CAP (1u << 18)
#define LAS __attribute__((address_space(3)))
DI unsigned xb_ld(unsigned* p)              { return __hip_atomic_load(p, __ATOMIC_RELAXED, __HIP_MEMORY_SCOPE_AGENT); }
DI unsigned xb_add(unsigned* p, unsigned v) { return __hip_atomic_fetch_add(p, v, __ATOMIC_RELAXED, __HIP_MEMORY_SCOPE_AGENT); }
DI unsigned xb_xcc_id() { return (unsigned)__builtin_amdgcn_s_getreg((3 << 11) | 20) & 0xFu; }
#define XB_SPIN(cond, bar) do { unsigned _sp = 0; while (cond) { __builtin_amdgcn_s_sleep(1); \
    if ((++_sp & 255u) == 0u) { if (xb_ld(&(bar)[XB_TMO])) break; if (_sp > XB_SPIN_CAP) { atomicAdd(&(bar)[XB_TMO], 1u); break; } } } } while (0)
struct XcdBarrier { unsigned* bar; unsigned x; volatile LAS unsigned* st; };
DI XcdBarrier xcd_barrier_post(unsigned* bar, volatile LAS unsigned* st) {
    XcdBarrier b; b.bar = bar; b.x = xb_xcc_id(); b.st = st;
    if (threadIdx.x == 0) (void)xb_add(&bar[XB_XCNT(b.x)], 1u);
    return b;
}
DI void xcd_barrier_complete(unsigned* bar, unsigned x, unsigned& nloc, unsigned& nx) {
    const unsigned G = gridDim.x * gridDim.y * gridDim.z;
    unsigned sum, cnt, mine, sp = 0u;
    for (;;) {
        sum = 0u; cnt = 0u; mine = 0u;
#pragma unroll
        for (unsigned j = 0; j < 16; ++j) { const unsigned c = xb_ld(&bar[XB_XCNT(j)]); sum += c; cnt += (c > 0u) ? 1u : 0u; mine = (j == x) ? c : mine; }
        if (sum == G) break;
        __builtin_amdgcn_s_sleep(1);
        if ((++sp & 255u) == 0u) { if (xb_ld(&bar[XB_TMO])) break; if (sp > XB_SPIN_CAP) { atomicAdd(&bar[XB_TMO], 1u); break; } }
    }
    nloc = mine > 0u ? mine : 1u; nx = cnt > 0u ? cnt : 1u;
}
DI void xcd_barrier(const XcdBarrier& b) {
    asm volatile("s_waitcnt vmcnt(0)" ::: "memory");
    __syncthreads();
    if (threadIdx.x == 0) {
        unsigned* bar = b.bar;
        __builtin_amdgcn_s_waitcnt(0);
        unsigned nloc = b.st[0], nx = b.st[1];
        if (nloc == 0u) { xcd_barrier_complete(bar, b.x, nloc, nx); b.st[0] = nloc; b.st[1] = nx; }
        const unsigned old = xb_add(&bar[XB_XSUB(b.x)], 1u);
        const unsigned gen = old / nloc;
        if (old + 1u == (gen + 1u) * nloc) {
            __builtin_amdgcn_fence(__ATOMIC_RELEASE, "agent");
            asm volatile("s_waitcnt vmcnt(0)" ::: "memory");
            const unsigned og = xb_add(&bar[XB_TOP], 1u);
            const unsigned tg = og / nx;
            if (og + 1u == (tg + 1u) * nx) xb_add(&bar[XB_TOPGEN], 1u);
            else XB_SPIN(xb_ld(&bar[XB_TOPGEN]) == tg, bar);
            __builtin_amdgcn_fence(__ATOMIC_ACQUIRE, "agent");
            xb_add(&bar[XB_XGEN(b.x)], 1u);
            asm volatile("s_waitcnt vmcnt(0)" ::: "memory");
        } else {
            XB_SPIN(xb_ld(&bar[XB_XGEN(b.x)]) == gen, bar);
            __builtin_amdgcn_fence(__ATOMIC_ACQUIRE, "agent");
            asm volatile("s_waitcnt vmcnt(0)" ::: "memory");
        }
    }
    __syncthreads();
}

__global__ void __launch_bounds__(512) fwd_megakernel(Params p) {
    cg::grid_group grid = cg::this_grid();
    unsigned* bar = (unsigned*)(p.ws + WS_BAR);
    volatile LAS unsigned* st = (volatile LAS unsigned*)(LAS unsigned char*)(smem + LDS_MAIN);
    if (threadIdx.x < 4) st[threadIdx.x] = 0u;
    if (blockIdx.x == 0) for (int i = threadIdx.x; i < XCD_BAR_WORDS; i += 512) bar[i] = 0u;
    prologue_phase(p);      grid.sync();
    const XcdBarrier xb = xcd_barrier_post(bar, st);
    gemm_job(p, 0);         xcd_barrier(xb);
    gemm_job(p, 1);         xcd_barrier(xb);
    row_job(p, 0);          xcd_barrier(xb);
    gemm_job(p, 2);         xcd_barrier(xb);
    attn_prep_phase(p); __syncthreads();
    rwkv_pass(p, 0);        xcd_barrier(xb);
    rwkv_chain(p); __syncthreads();
    attn_phase(p);          xcd_barrier(xb);
    rwkv_pass(p, 1);        xcd_barrier(xb);
    ypost_phase(p);         xcd_barrier(xb);
    row_job(p, 1);          xcd_barrier(xb);
    gemm_job(p, 3);         xcd_barrier(xb);
    gemm_job(p, 4);         xcd_barrier(xb);
    row_job(p, 2);          xcd_barrier(xb);
    gemm_job(p, 5);         xcd_barrier(xb);
    gemm_job(p, 6);         xcd_barrier(xb);
    row_job(p, 3);
}

extern "C" void kernel_launch(void* const* d_in, const int* in_sizes, int n_in, void* d_out, int out_size, void* d_ws, size_t ws_size, hipStream_t stream) {
    static int grid_blocks = 0;
    if (grid_blocks == 0) {
        if (n_in != 23 || out_size != MTOK * DM || ws_size < WS_NEED) { fprintf(stderr, "kernel_launch: unexpected sizes n_in %d out %d ws %zu\n", n_in, out_size, ws_size); grid_blocks = -1; return; }
        int dev = 0, cus = 0, per_cu = 0;
        hipGetDevice(&dev); hipDeviceGetAttribute(&cus, hipDeviceAttributeMultiprocessorCount, dev);
        if (hipFuncSetAttribute((const void*)fwd_megakernel, hipFuncAttributeMaxDynamicSharedMemorySize, LDS_BYTES) != hipSuccess) { fprintf(stderr, "hipFuncSetAttribute failed\n"); }
        if (hipOccupancyMaxActiveBlocksPerMultiprocessor(&per_cu, (const void*)fwd_megakernel, 512, LDS_BYTES) != hipSuccess || per_cu < 1) { fprintf(stderr, "occupancy query: %d\n", per_cu); per_cu = 1; }
        (void)hipGetLastError();
        grid_blocks = cus * 1;
        if (grid_blocks > 256) grid_blocks = 256;
    }
    if (grid_blocks < 0) return;
    Params p{};
    const float* const* in = (const float* const*)d_in;
    p.xp = in[0]; p.xs = in[1]; p.norm_g = in[2]; p.ffn_wg = in[3]; p.ffn_wu = in[4]; p.ffn_wd = in[5]; p.w_in = in[6]; p.mu = in[7]; p.w0 = in[8]; p.w_up = in[9];
    p.a0 = in[10]; p.a_up = in[11]; p.g_up = in[12]; p.k_k = in[13]; p.k_a = in[14]; p.r_k = in[15]; p.lnx_w = in[16]; p.lnx_b = in[17]; p.qk_g = in[18];
    p.w_ba = in[19]; p.w_bb = in[20]; p.b_gate = in[21]; p.w_out = in[22];
    p.out = (float*)d_out; p.ws = (unsigned char*)d_ws;
    void* args[] = {&p};
    hipError_t e = hipLaunchCooperativeKernel((void*)fwd_megakernel, dim3(grid_blocks), dim3(512), args, LDS_BYTES, stream);
    if (e != hipSuccess) fprintf(stderr, "cooperative launch failed: %s (grid %d)\n", hipGetErrorString(e), grid_blocks);
}
```
